# Optimizing an MI355X kernel written in HIP

```python
import math
import jax, jax.numpy as jnp
from jax import lax
import numpy as np

D_MODEL = 2048
BATCH = 2
SEQ = 4096
DEPTH = 1

GLA_WIDTH = D_MODEL // 2
FOX_WIDTH = D_MODEL - GLA_WIDTH
GLA_HEADS = 4
GLA_DV = GLA_WIDTH // GLA_HEADS
GLA_DK = GLA_DV // 2
GLA_LOWRANK = 16
GLA_TAU = 16.0
GLA_CHUNK = 64
FOX_HEADS = 8
FOX_DH = FOX_WIDTH // FOX_HEADS
Q_BLOCK = 128
FOX_GATE_BIAS = 2.0
SPLITS = (GLA_HEADS * GLA_DK, GLA_HEADS * GLA_DK, GLA_WIDTH, GLA_WIDTH, GLA_LOWRANK,
          FOX_WIDTH, FOX_WIDTH, FOX_WIDTH, FOX_HEADS)
D_IN = sum(SPLITS)
MEM_LEN = 256
XATTN_HEADS = 4
XATTN_DH = D_MODEL // XATTN_HEADS
N_EXPERTS = 32
TOP_K = 4
D_FF = D_MODEL
SWIGLU_LIMIT = 7.0
SWIGLU_ALPHA = 1.702
EXPERT_BLOCK = 128
EPS = 1e-6

kernel_name = "hymba_gla_fox_memxattn_gptoss_moe"


def rmsnorm(x, g):
    xf = x.astype(jnp.float32)
    y = xf * lax.rsqrt(jnp.mean(xf * xf, axis=-1, keepdims=True) + EPS)
    return (y * g.astype(jnp.float32)).astype(x.dtype)


def gla_chunked(q, k, v, log_a):
    B, S, H, DK = q.shape
    DV = v.shape[-1]
    C = GLA_CHUNK
    N = S // C

    def chunks(t):
        return t.astype(jnp.float32).reshape(B, N, C, H, t.shape[-1]).transpose(0, 3, 1, 2, 4)

    q, k, v, g = chunks(q), chunks(k), chunks(v), chunks(log_a)
    G = jnp.cumsum(g, axis=3)
    G_last = G[:, :, :, -1:, :]
    q_in = q * jnp.exp(G)
    k_in = k * jnp.exp(-G)
    causal = jnp.tril(jnp.ones((C, C), dtype=bool))
    A = jnp.where(causal, jnp.einsum('bhnck,bhnsk->bhncs', q_in, k_in), 0.0)
    o_intra = jnp.einsum('bhncs,bhnsv->bhncv', A, v)
    k_to_end = k * jnp.exp(G_last - G)
    chunk_kv = jnp.einsum('bhnck,bhncv->bhnkv', k_to_end, v)
    chunk_decay = jnp.exp(G_last[:, :, :, 0, :])

    def step(state, inp):
        decay_n, kv_n = inp
        return decay_n[..., None] * state + kv_n, state

    _, states_before = lax.scan(step, jnp.zeros((B, H, DK, DV), jnp.float32),
                                (jnp.moveaxis(chunk_decay, 2, 0), jnp.moveaxis(chunk_kv, 2, 0)))
    states_before = jnp.moveaxis(states_before, 0, 2)
    o_inter = jnp.einsum('bhnck,bhnkv->bhncv', q_in, states_before)
    return (o_intra + o_inter).transpose(0, 2, 3, 1, 4).reshape(B, S, H, DV)


def forgetting_attention(q, k, v, log_f):
    B, S, H, d = q.shape
    nb = S // Q_BLOCK
    scale = d ** -0.5
    k = k.transpose(0, 2, 1, 3)
    v = v.transpose(0, 2, 1, 3)
    c = jnp.cumsum(log_f, axis=1).transpose(0, 2, 1)
    qb = q.transpose(0, 2, 1, 3).reshape(B, H, nb, Q_BLOCK, d).transpose(2, 0, 1, 3, 4)
    cb = c.reshape(B, H, nb, Q_BLOCK).transpose(2, 0, 1, 3)
    kpos = jnp.arange(S)

    def block(args):
        q_blk, c_blk, i = args
        qpos = i * Q_BLOCK + jnp.arange(Q_BLOCK)
        logits = (jnp.einsum('bhqd,bhkd->bhqk', q_blk, k).astype(jnp.float32) * scale
                  + c_blk[..., :, None] - c[..., None, :])
        logits = jnp.where(kpos[None, :] <= qpos[:, None], logits, -jnp.inf)
        p = jax.nn.softmax(logits, axis=-1)
        return jnp.einsum('bhqk,bhkd->bhqd', p.astype(v.dtype), v)

    out = lax.map(block, (qb, cb, jnp.arange(nb)))
    return out.transpose(1, 0, 3, 2, 4).reshape(B, S, H * d)


def hybrid_mixer(xn, w_in, w_alpha_up, b_alpha, b_fgate, gla_norm, w_out):
    B, S, _ = xn.shape
    proj = xn @ w_in
    idx = [int(i) for i in np.cumsum(SPLITS)[:-1]]
    gq, gk, gv, gr, ga, fq, fk, fv, ff = jnp.split(proj, idx, axis=-1)
    q = gq.reshape(B, S, GLA_HEADS, GLA_DK) * (GLA_DK ** -0.5)
    k = gk.reshape(B, S, GLA_HEADS, GLA_DK)
    v = gv.reshape(B, S, GLA_HEADS, GLA_DV)
    log_a = jax.nn.log_sigmoid((ga @ w_alpha_up + b_alpha).astype(jnp.float32)) / GLA_TAU
    log_a = log_a.reshape(B, S, GLA_HEADS, GLA_DK)
    o_gla = rmsnorm(gla_chunked(q, k, v, log_a), gla_norm).astype(xn.dtype)
    o_gla = o_gla.reshape(B, S, GLA_WIDTH) * jax.nn.silu(gr)
    log_f = jax.nn.log_sigmoid((ff + b_fgate).astype(jnp.float32))
    o_fox = forgetting_attention(fq.reshape(B, S, FOX_HEADS, FOX_DH),
                                 fk.reshape(B, S, FOX_HEADS, FOX_DH),
                                 fv.reshape(B, S, FOX_HEADS, FOX_DH), log_f)
    return jnp.concatenate([o_gla, o_fox.astype(xn.dtype)], axis=-1) @ w_out


def memory_cross_attention(xn, mem_n, w_xq, w_xkv, w_xo):
    B, S, _ = xn.shape
    M = mem_n.shape[1]
    q = (xn @ w_xq).reshape(B, S, XATTN_HEADS, XATTN_DH)
    k, v = jnp.split(mem_n @ w_xkv, 2, axis=-1)
    k = k.reshape(B, M, XATTN_HEADS, XATTN_DH)
    v = v.reshape(B, M, XATTN_HEADS, XATTN_DH)
    logits = jnp.einsum('bshd,bmhd->bhsm', q, k).astype(jnp.float32) * (XATTN_DH ** -0.5)
    p = jax.nn.softmax(logits, axis=-1).astype(v.dtype)
    o = jnp.einsum('bhsm,bmhd->bshd', p, v).reshape(B, S, XATTN_HEADS * XATTN_DH)
    return o @ w_xo


def routed_experts(xn, w_router, b_router, w_gate_up, b_gate_up, w_down, b_down):
    B, S, D = xn.shape
    T = B * S
    TK = T * TOP_K
    xf = xn.reshape(T, D)
    logits = (xf @ w_router + b_router).astype(jnp.float32)
    top_vals, top_idx = lax.top_k(logits, TOP_K)
    gates = jax.nn.softmax(top_vals, axis=-1).astype(xn.dtype)
    flat_e = top_idx.reshape(-1).astype(jnp.int32)
    flat_tok = jnp.arange(TK, dtype=jnp.int32) // TOP_K
    flat_gate = gates.reshape(-1)
    order = jnp.argsort(flat_e, stable=True)
    sorted_e = flat_e[order]
    counts = jnp.bincount(flat_e, length=N_EXPERTS)
    padded = ((counts + EXPERT_BLOCK - 1) // EXPERT_BLOCK) * EXPERT_BLOCK
    pad_end = jnp.cumsum(padded)
    pad_start = pad_end - padded
    start = jnp.cumsum(counts) - counts
    dest = pad_start[sorted_e] + jnp.arange(TK, dtype=jnp.int32) - start[sorted_e]
    NB = -(-TK // EXPERT_BLOCK) + N_EXPERTS
    P = NB * EXPERT_BLOCK
    slot_tok = jnp.zeros((P,), jnp.int32).at[dest].set(flat_tok[order])
    slot_gate = jnp.zeros((P,), xn.dtype).at[dest].set(flat_gate[order])
    block_start = jnp.arange(NB, dtype=jnp.int32) * EXPERT_BLOCK
    block_e = jnp.minimum(jnp.sum(pad_end[None, :] <= block_start[:, None], axis=1),
                          N_EXPERTS - 1).astype(jnp.int32)
    xs = xf[slot_tok].reshape(NB, EXPERT_BLOCK, D)

    def expert_block(args):
        xb, e = args
        gu = xb @ w_gate_up[e] + b_gate_up[e]
        g, u = gu[:, 0::2], gu[:, 1::2]
        g = jnp.minimum(g, SWIGLU_LIMIT)
        u = jnp.clip(u, -SWIGLU_LIMIT, SWIGLU_LIMIT)
        h = (u + 1.0) * (g * jax.nn.sigmoid(SWIGLU_ALPHA * g))
        return h @ w_down[e] + b_down[e]

    y = lax.map(expert_block, (xs, block_e)).reshape(P, D)
    out = jnp.zeros((T, D), xn.dtype).at[slot_tok].add(y * slot_gate[:, None])
    return out.reshape(B, S, D)


def setup_inputs(seed: int = 0) -> dict:
    key = jax.random.key(seed)
    ks = jax.random.split(key, 24)
    L, D, E, F = DEPTH, D_MODEL, N_EXPERTS, D_FF
    XW = XATTN_HEADS * XATTN_DH

    def nrm(k, shape, scale):
        return jax.random.normal(k, shape, jnp.float32) * scale

    return {
        "x": nrm(ks[0], (BATCH, SEQ, D), 1.0),
        "mem": nrm(ks[1], (BATCH, MEM_LEN, D), 1.0),
        "norm_mix": 1.0 + nrm(ks[2], (L, D), 0.02),
        "w_in": nrm(ks[3], (L, D, D_IN), D ** -0.5),
        "w_alpha_up": nrm(ks[4], (L, GLA_LOWRANK, GLA_HEADS * GLA_DK), GLA_LOWRANK ** -0.5),
        "b_alpha": nrm(ks[5], (L, GLA_HEADS * GLA_DK), 0.1),
        "b_fgate": FOX_GATE_BIAS + nrm(ks[6], (L, FOX_HEADS), 0.1),
        "gla_norm": 1.0 + nrm(ks[7], (L, GLA_DV), 0.02),
        "w_out": nrm(ks[8], (L, D, D), D ** -0.5),
        "norm_xattn": 1.0 + nrm(ks[9], (L, D), 0.02),
        "norm_mem": 1.0 + nrm(ks[10], (L, D), 0.02),
        "w_xq": nrm(ks[11], (L, D, XW), D ** -0.5),
        "w_xkv": nrm(ks[12], (L, D, 2 * XW), D ** -0.5),
        "w_xo": nrm(ks[13], (L, XW, D), XW ** -0.5),
        "norm_moe": 1.0 + nrm(ks[14], (L, D), 0.02),
        "w_router": nrm(ks[15], (L, D, E), D ** -0.5),
        "b_router": nrm(ks[16], (L, E), 0.01),
        "w_gate_up": nrm(ks[17], (L, E, D, 2 * F), D ** -0.5),
        "b_gate_up": nrm(ks[18], (L, E, 2 * F), 0.01),
        "w_down": nrm(ks[19], (L, E, F, D), F ** -0.5),
        "b_down": nrm(ks[20], (L, E, D), 0.01),
        "norm_final": 1.0 + nrm(ks[21], (D,), 0.02),
    }


def reference(x, mem, norm_mix, w_in, w_alpha_up, b_alpha, b_fgate, gla_norm, w_out,
              norm_xattn, norm_mem, w_xq, w_xkv, w_xo, norm_moe, w_router, b_router,
              w_gate_up, b_gate_up, w_down, b_down, norm_final):
    h = x
    for l in range(DEPTH):
        h = h + hybrid_mixer(rmsnorm(h, norm_mix[l]), w_in[l], w_alpha_up[l], b_alpha[l],
                             b_fgate[l], gla_norm[l], w_out[l])
        h = h + memory_cross_attention(rmsnorm(h, norm_xattn[l]), rmsnorm(mem, norm_mem[l]),
                                       w_xq[l], w_xkv[l], w_xo[l])
        h = h + routed_experts(rmsnorm(h, norm_moe[l]), w_router[l], b_router[l],
                               w_gate_up[l], b_gate_up[l], w_down[l], b_down[l])
    return rmsnorm(h, norm_final)
```

```cpp
#include <hip/hip_runtime.h>
#include <cstdio>
#include <cstdint>
#define GAS __attribute__((address_space(1)))
#define LAS __attribute__((address_space(3)))
__device__ __forceinline__ void glds16s(const void* sbase, unsigned voff, unsigned lds_dst) { unsigned keep;
    asm volatile("s_mov_b32 %0, m0\n\ts_mov_b32 m0, %3\n\ts_nop 0\n\tglobal_load_lds_dwordx4 %1, %2\n\ts_mov_b32 m0, %0" : "=&s"(keep) : "v"(voff), "s"(sbase), "s"(lds_dst) : "memory"); }
__device__ __forceinline__ void glds4s(const void* sbase, unsigned voff, unsigned lds_dst) { unsigned keep;
    asm volatile("s_mov_b32 %0, m0\n\ts_mov_b32 m0, %3\n\ts_nop 0\n\tglobal_load_lds_dword %1, %2\n\ts_mov_b32 m0, %0" : "=&s"(keep) : "v"(voff), "s"(sbase), "s"(lds_dst) : "memory"); }
__device__ __forceinline__ int lane_id() { int r; asm volatile("v_mbcnt_lo_u32_b32 %0, -1, 0\n\tv_mbcnt_hi_u32_b32 %0, -1, %0" : "=v"(r)); return r; }
namespace pg8 {
#define PG8_LAS __attribute__((address_space(3)))
typedef unsigned short bf16_t;
typedef short bf16x8 __attribute__((ext_vector_type(8)));
typedef float f32x4 __attribute__((ext_vector_type(4)));
typedef unsigned u32x4 __attribute__((ext_vector_type(4)));
typedef unsigned u32x2 __attribute__((ext_vector_type(2)));
typedef int v8i32 __attribute__((ext_vector_type(8)));
constexpr int BM = 256, BK = 64, HALF = 128, HTB = HALF * BK * 2  , STAGE_BYTES = 8 * HTB, NXCD = 8, WGM = 8;

__host__ __device__ __forceinline__ int lds_byte(int r, int c) { const int st = (r >> 4) * 2 + (c >> 5), rr = r & 15, cc = c & 31, ob = rr * 64 + cc * 2; return st * 1024 + (ob ^ (((ob >> 9) & 1) << 5)); }
__host__ __device__ __forceinline__ void stage_rc(int b, int& R, int& C) { const int st = b / 1024, sb = b % 1024, swz = sb ^ (((sb >> 9) & 1) << 5); R = (st >> 1) * 16 + swz / 64; C = (st & 1) * 32 + (swz % 64) / 2; }
__host__ __device__ __forceinline__ int perm32(int rho) { const int n = rho >> 4, i = rho & 15; return 8 * (i >> 2) + 4 * n + (i & 3); }

struct Unit { int pn, a128, nrows; };
struct Gemm { const bf16_t* A; const bf16_t* Bt; int M, N, K; int ld = 0; };

struct StaticOrder {
    int nM, nN, nwg, G, c;
    __host__ __device__ void init(int M, int N, int G_, int c_) { nM = M / BM; nN = N / BM; nwg = nM * nN; G = G_; c = c_; }
    __host__ __device__ bool next(int i, Unit& u) const {
        const long L = (long)i * G + c; if (L >= nwg) return false;
        int wgid = (int)L; { const int q = nwg / NXCD, r = nwg % NXCD, xcd = wgid % NXCD, off = wgid / NXCD; wgid = (xcd < r ? xcd * (q + 1) : r * (q + 1) + (xcd - r) * q) + off; }
        const int nig = WGM * nN, gid = wgid / nig, fm = gid * WGM, gsz = (nM - fm) < WGM ? (nM - fm) : WGM;
        u.a128 = 2 * (fm + ((wgid % nig) % gsz)); u.pn = (wgid % nig) / gsz; u.nrows = 256; return true;
    }
    __device__ __forceinline__ void a_ready(const Unit&) const {}
    __device__ __forceinline__ void done(const Unit&) const {}
};
struct HalfOrder {
    int nrb, nN, first, stride;
    __device__ __forceinline__ bool next(int i, Unit& u) const { const int L = first + i * stride; if (L < 0 || L >= nrb * nN) return false; u.a128 = L % nrb; u.pn = L / nrb; u.nrows = 128; return true; }
    __device__ __forceinline__ void a_ready(const Unit&) const {}
    __device__ __forceinline__ void done(const Unit&) const {}
};
struct MoeOrder {
    const int* ul; int nwg, G, c, split; const PG8_LAS int* tab;
    __device__ __forceinline__ bool raw(int i, int& a128, int& nrows, int& pn) const {
        int L = i * G + c; const int rem = nwg - i * G;
        const bool halves = split && rem > 0 && 2 * rem <= G;
        if (halves) { if (c >= 2 * rem) return false; L = i * G + (c >> 1); }
        if (L >= nwg) return false;
        int wgid = L; { const int q = nwg / NXCD, r = nwg % NXCD, xcd = wgid % NXCD, off = wgid / NXCD; wgid = (xcd < r ? xcd * (q + 1) : r * (q + 1) + (xcd - r) * q) + off; }
        a128 = ul[3 * wgid]; nrows = ul[3 * wgid + 1]; pn = ul[3 * wgid + 2];
        if (halves) { if (c & 1) { if (nrows <= 128) return false; a128 += 1; nrows -= 128; } else if (nrows > 128) nrows = 128; }
        return true;
    }
    __device__ __forceinline__ void fill(PG8_LAS int* t, int tid) const {
        if (tid < 16) { int a = 0, n = 0, p = 0; const bool ok = raw(tid, a, n, p); t[4 * tid] = ok ? 1 : 0; t[4 * tid + 1] = a; t[4 * tid + 2] = n; t[4 * tid + 3] = p; }
    }
    __device__ __forceinline__ bool next(int i, Unit& u) const {
        if (i >= 16) return false;
        const PG8_LAS int* e = tab + 4 * i;
        const int ok = __builtin_amdgcn_readfirstlane(e[0]); u.a128 = __builtin_amdgcn_readfirstlane(e[1]); u.nrows = __builtin_amdgcn_readfirstlane(e[2]); u.pn = __builtin_amdgcn_readfirstlane(e[3]);
        return ok != 0;
    }
    __device__ __forceinline__ void a_ready(const Unit&) const {}
    __device__ __forceinline__ void done(const Unit&) const {}
};
__device__ __forceinline__ unsigned cvt_pk_bf16(float lo, float hi) { unsigned r; asm volatile("v_cvt_pk_bf16_f32 %0, %1, %2" : "=v"(r) : "v"(lo), "v"(hi)); return r; }
struct EpiBf16S {
    static constexpr bool PERM = true, AFTER_DRAIN = false;
    bf16_t* O; int ldc; float scale; int nsc; const PG8_LAS float* rstd;
    __device__ __forceinline__ void operator()(const f32x4 (&acc)[2][2][4][2], const Unit& u, int wr, int wc, int fr, int fq) const {
        asm volatile("" : "+v"(fr), "+v"(fq));
        const int lrow0 = wr * 64 + fr; const int row0 = u.a128 * 128 + lrow0; const int col0 = u.pn * BM + wc * 32 + 8 * fq;
        const float sc = (u.pn < nsc) ? scale : 1.f;
#pragma unroll
        for (int ai = 0; ai < 2; ++ai)
#pragma unroll
            for (int m = 0; m < 4; ++m) { if (lrow0 + ai * HALF + m * 16 < u.nrows) { bf16_t* rowp = O + (size_t)(row0 + ai * HALF + m * 16) * ldc + col0;
                float rs = sc; if (rstd) rs *= rstd[lrow0 + ai * HALF + m * 16];
#pragma unroll
                for (int bj = 0; bj < 2; ++bj) { const f32x4 v0 = acc[ai][bj][m][0] * rs, v1 = acc[ai][bj][m][1] * rs;
                    u32x4 w; w.x = cvt_pk_bf16(v0[0], v0[1]); w.y = cvt_pk_bf16(v0[2], v0[3]); w.z = cvt_pk_bf16(v1[0], v1[1]); w.w = cvt_pk_bf16(v1[2], v1[3]);
                    *(u32x4*)(rowp + bj * HALF) = w; } } }
    }
};
struct EpiF32ResNorm {
    static constexpr bool PERM = false, AFTER_DRAIN = false;
    const float* base; float* out; int ldc; const float* gain; unsigned char* XG; float* SSP; float xscale;
    __device__ __forceinline__ void operator()(const f32x4 (&acc)[2][2][4][2], const Unit& u, int wr, int wc, int fr, int fq) const {
        asm volatile("" : "+v"(fr), "+v"(fq));
        const int row0 = u.a128 * 128 + wr * 64 + fr; const int col0 = u.pn * BM + wc * 32 + 4 * fq;
        f32x4 gv[2][2];
#pragma unroll
        for (int bj = 0; bj < 2; ++bj)
#pragma unroll
            for (int n = 0; n < 2; ++n) gv[bj][n] = *(const f32x4*)(gain + col0 + bj * HALF + n * 16);
#pragma unroll
        for (int ai = 0; ai < 2; ++ai) {
            f32x4 pre[4][2][2];
#pragma unroll
            for (int m = 0; m < 4; ++m) { const size_t off = (size_t)(row0 + ai * HALF + m * 16) * ldc + col0;
#pragma unroll
                for (int bj = 0; bj < 2; ++bj)
#pragma unroll
                    for (int n = 0; n < 2; ++n) pre[m][bj][n] = *(const f32x4*)(base + off + bj * HALF + n * 16); }
#pragma unroll
            for (int m = 0; m < 4; ++m) { const int row = row0 + ai * HALF + m * 16; const size_t off = (size_t)row * ldc + col0; float ss = 0.f;
#pragma unroll
                for (int bj = 0; bj < 2; ++bj)
#pragma unroll
                    for (int n = 0; n < 2; ++n) { const f32x4 o = pre[m][bj][n] + acc[ai][bj][m][n];
                        *(f32x4*)(out + off + bj * HALF + n * 16) = o; ss += (o.x * o.x + o.y * o.y) + (o.z * o.z + o.w * o.w);
                        const f32x4 y = o * gv[bj][n] * xscale; int w = 0; w = __builtin_amdgcn_cvt_pk_fp8_f32(y.x, y.y, w, false); w = __builtin_amdgcn_cvt_pk_fp8_f32(y.z, y.w, w, true); *(int*)(XG + off + bj * HALF + n * 16) = w; }
                ss += __shfl_xor(ss, 16); ss += __shfl_xor(ss, 32);
                if (fq == 0) SSP[(size_t)row * 32 + u.pn * 4 + wc] = ss; }
        }
    }
};
struct EpiF32Res {
    static constexpr bool PERM = false, AFTER_DRAIN = false;
    const float* base; float* out; int ldc; float ascale;
    __device__ __forceinline__ void operator()(const f32x4 (&acc)[2][2][4][2], const Unit& u, int wr, int wc, int fr, int fq) const {
        asm volatile("" : "+v"(fr), "+v"(fq));
        const int row0 = u.a128 * 128 + wr * 64 + fr; const int col0 = u.pn * BM + wc * 32 + 4 * fq;
#pragma unroll
        for (int ai = 0; ai < 2; ++ai) {
            f32x4 pre[4][2][2];
#pragma unroll
            for (int m = 0; m < 4; ++m) { const size_t off = (size_t)(row0 + ai * HALF + m * 16) * ldc + col0;
#pragma unroll
                for (int bj = 0; bj < 2; ++bj)
#pragma unroll
                    for (int n = 0; n < 2; ++n) pre[m][bj][n] = *(const f32x4*)(base + off + bj * HALF + n * 16); }
#pragma unroll
            for (int m = 0; m < 4; ++m) { const size_t off = (size_t)(row0 + ai * HALF + m * 16) * ldc + col0;
#pragma unroll
                for (int bj = 0; bj < 2; ++bj)
#pragma unroll
                    for (int n = 0; n < 2; ++n) *(f32x4*)(out + off + bj * HALF + n * 16) = pre[m][bj][n] + acc[ai][bj][m][n] * ascale; }
        }
    }
};
struct EpiGateUp {
    static constexpr bool PERM = true, AFTER_DRAIN = false;
    unsigned char* H; int ldh; const float* bias; float ascale, oscale;
    static __device__ __forceinline__ float act(float g, float uu) {
        g = fminf(g, 7.f); uu = fminf(fmaxf(uu, -7.f), 7.f);
        const float s = __builtin_amdgcn_rcpf(1.f + __builtin_amdgcn_exp2f(-1.702f * 1.4426950408889634f * g)); return (uu + 1.f) * (g * s);
    }
    __device__ __forceinline__ void operator()(const f32x4 (&acc)[2][2][4][2], const Unit& u, int wr, int wc, int fr, int fq) const {
        asm volatile("" : "+v"(fr), "+v"(fq));
        const int lrow0 = wr * 64 + fr; const int lcol0 = wc * 32 + 8 * fq;
        const int ue = u.pn >> 4, upnl = u.pn & 15;
        const float* bp = bias + (size_t)ue * 4096 + upnl * BM + lcol0;
        f32x4 bv[2][2];
#pragma unroll
        for (int bj = 0; bj < 2; ++bj)
#pragma unroll
            for (int n = 0; n < 2; ++n) bv[bj][n] = *(const f32x4*)(bp + bj * HALF + 4 * n);
        asm volatile("" : "+v"(bv[0][0]), "+v"(bv[0][1]), "+v"(bv[1][0]), "+v"(bv[1][1]));
#pragma unroll
        for (int ai = 0; ai < 2; ++ai)
#pragma unroll
            for (int m = 0; m < 4; ++m) { const int lr = lrow0 + ai * HALF + m * 16;
                if (lr < u.nrows) { unsigned char* rowp = H + (size_t)(u.a128 * 128 + lr) * ldh + upnl * 128 + (lcol0 >> 1);
#pragma unroll
                    for (int bj = 0; bj < 2; ++bj) { const f32x4 v0 = acc[ai][bj][m][0] * ascale + bv[bj][0], v1 = acc[ai][bj][m][1] * ascale + bv[bj][1];
                        int w = 0; w = __builtin_amdgcn_cvt_pk_fp8_f32(act(v0[0], v0[1]) * oscale, act(v0[2], v0[3]) * oscale, w, false);
                        w = __builtin_amdgcn_cvt_pk_fp8_f32(act(v1[0], v1[1]) * oscale, act(v1[2], v1[3]) * oscale, w, true);
                        *(int*)(rowp + bj * 64) = w; } } }
    }
};
struct EpiDown {
    static constexpr bool PERM = true, AFTER_DRAIN = false;
    unsigned char* Y; int ldy; const float* bias; float ascale, yscale;
    __device__ __forceinline__ void operator()(const f32x4 (&acc)[2][2][4][2], const Unit& u, int wr, int wc, int fr, int fq) const {
        asm volatile("" : "+v"(fr), "+v"(fq));
        const int ue = u.pn >> 3, upnl = u.pn & 7;
        const int lrow0 = wr * 64 + fr; const int lcol0 = upnl * BM + wc * 32 + 8 * fq;
        const float* bp = bias + (size_t)ue * 2048 + lcol0;
        f32x4 bv[2][2];
#pragma unroll
        for (int bj = 0; bj < 2; ++bj)
#pragma unroll
            for (int n = 0; n < 2; ++n) bv[bj][n] = *(const f32x4*)(bp + bj * HALF + 4 * n);
        asm volatile("" : "+v"(bv[0][0]), "+v"(bv[0][1]), "+v"(bv[1][0]), "+v"(bv[1][1]));
#pragma unroll
        for (int ai = 0; ai < 2; ++ai)
#pragma unroll
            for (int m = 0; m < 4; ++m) { const int lr = lrow0 + ai * HALF + m * 16;
                if (lr < u.nrows) { unsigned char* rowp = Y + (size_t)(u.a128 * 128 + lr) * ldy + lcol0;
#pragma unroll
                    for (int bj = 0; bj < 2; ++bj) { const f32x4 v0 = (acc[ai][bj][m][0] * ascale + bv[bj][0]) * yscale, v1 = (acc[ai][bj][m][1] * ascale + bv[bj][1]) * yscale;
                        int w0 = 0, w1 = 0; w0 = __builtin_amdgcn_cvt_pk_fp8_f32(v0[0], v0[1], w0, false); w0 = __builtin_amdgcn_cvt_pk_fp8_f32(v0[2], v0[3], w0, true);
                        w1 = __builtin_amdgcn_cvt_pk_fp8_f32(v1[0], v1[1], w1, false); w1 = __builtin_amdgcn_cvt_pk_fp8_f32(v1[2], v1[3], w1, true);
                        u32x2 w; w.x = (unsigned)w0; w.y = (unsigned)w1; *(u32x2*)(rowp + bj * HALF) = w; } } }
    }
};
template <class Epi, class Sched, bool ALIGN_EPI = false, bool SP2 = false, bool FP8 = false, bool HALF_OK = false>
__device__ __forceinline__ void gemm_phase(PG8_LAS unsigned char* lds, const Gemm g, const Sched& S, const Epi& E, const int wid  ) {
    const int lane = lane_id(), tid = wid * 64 + lane, wr = wid >> 2, wc = wid & 3, fr = lane & 15, fq = lane >> 4;
    const int K = g.K, nt = K / BK, LD = g.ld ? g.ld : g.K;
    unsigned voffA[2], voffB[2];
#pragma unroll
    for (int i = 0; i < 2; ++i) { int R, C; stage_rc(tid * 16 + i * 8192, R, C); const int Rb = Epi::PERM ? ((R & ~31) + perm32(R & 31)) : R;
        voffA[i] = (unsigned)(R * LD + C) * 2u; voffB[i] = (unsigned)(Rb * LD + C) * 2u; }
    const size_t kstep = (size_t)(BK * 2);
    const size_t hstep = (size_t)HALF * LD * 2;
    const size_t tstep = 2 * hstep;
    const unsigned ldsw = (unsigned)wid * 1024u;
    const unsigned ldsb = (unsigned)(unsigned long long)lds + ldsw;
    const int aoff = lds_byte(wr * 64 + fr, fq * 8), boff = lds_byte(wc * 32 + fr, fq * 8);
#define PG8_SA(b, h) (((b) * 2 + (h)) * HTB)
#define PG8_SB(b, h) ((4 + (b) * 2 + (h)) * HTB)
#define PG8_STAGE(bufoff, gbase, voff) do { _Pragma("unroll") for (int _i = 0; _i < 2; ++_i) \
        glds16s((const void*)(gbase), (voff)[_i], ldsb + (unsigned)((bufoff) + _i * 8192)); } while (0)
#define PG8_LDA(dst, b, h) do { _Pragma("unroll") for (int m = 0; m < 4; ++m) _Pragma("unroll") for (int k = 0; k < 2; ++k) dst[m][k] = *(const PG8_LAS bf16x8*)(lds + PG8_SA(b, h) + aoff + m * 2048 + k * 1024); } while (0)
#define PG8_LDB(dst, b, h) do { _Pragma("unroll") for (int n = 0; n < 2; ++n) _Pragma("unroll") for (int k = 0; k < 2; ++k) dst[n][k] = *(const PG8_LAS bf16x8*)(lds + PG8_SB(b, h) + boff + n * 2048 + k * 1024); } while (0)
#define PG8_MMA(ai, bj, At, Bt) do { __builtin_amdgcn_s_setprio(1); _Pragma("unroll") for (int m = 0; m < 4; ++m) _Pragma("unroll") for (int n = 0; n < 2; ++n) { \
        if constexpr (FP8) { acc[ai][bj][m][n] = __builtin_amdgcn_mfma_scale_f32_16x16x128_f8f6f4(__builtin_bit_cast(v8i32, __builtin_shufflevector(Bt[n][0], Bt[n][1], 0, 1, 2, 3, 4, 5, 6, 7, 8, 9, 10, 11, 12, 13, 14, 15)), \
                __builtin_bit_cast(v8i32, __builtin_shufflevector(At[m][0], At[m][1], 0, 1, 2, 3, 4, 5, 6, 7, 8, 9, 10, 11, 12, 13, 14, 15)), acc[ai][bj][m][n], 0, 0, 0, 0x7F7F7F7F, 0, 0x7F7F7F7F); } \
        else { _Pragma("unroll") for (int k = 0; k < 2; ++k) acc[ai][bj][m][n] = __builtin_amdgcn_mfma_f32_16x16x32_bf16(Bt[n][k], At[m][k], acc[ai][bj][m][n], 0, 0, 0); } } \
        __builtin_amdgcn_s_setprio(0); } while (0)
#define PG8_WAIT_V(n) asm volatile("s_waitcnt vmcnt(" #n ")" ::: "memory")
#define PG8_WAIT_L(n) asm volatile("s_waitcnt lgkmcnt(" #n ")" ::: "memory")
#define PG8_BAR __builtin_amdgcn_s_barrier()
#define PG8_SCHED __builtin_amdgcn_sched_barrier(0)
    Unit cur, nxt; int ui = 0;
    if (!S.next(0, cur)) return;
    f32x4 acc[2][2][4][2];
#pragma unroll
    for (int a = 0; a < 2; ++a)
#pragma unroll
        for (int b = 0; b < 2; ++b)
#pragma unroll
            for (int m = 0; m < 4; ++m)
#pragma unroll
                for (int n = 0; n < 2; ++n) acc[a][b][m][n] = (f32x4){0.f, 0.f, 0.f, 0.f};
    bf16x8 At[4][2], B0[2][2], B1[2][2];
    const char* cA = (const char*)g.A + (size_t)cur.a128 * hstep; const char* cB = (const char*)g.Bt + (size_t)cur.pn * tstep;
    S.a_ready(cur);
    if constexpr (SP2) {
        PG8_STAGE(PG8_SB(0, 0), cB, voffB); PG8_STAGE(PG8_SB(0, 1), cB + hstep, voffB); PG8_STAGE(PG8_SA(0, 0), cA, voffA); PG8_STAGE(PG8_SA(0, 1), cA + hstep, voffA);
        if (wr == 1) PG8_BAR;
        PG8_WAIT_V(2); PG8_BAR;
        PG8_STAGE(PG8_SB(1, 0), cB + kstep, voffB); PG8_STAGE(PG8_SA(1, 0), cA + kstep, voffA); PG8_STAGE(PG8_SB(1, 1), cB + hstep + kstep, voffB);
        PG8_WAIT_V(6); PG8_BAR;
    } else {
        PG8_STAGE(PG8_SB(0, 0), cB, voffB); PG8_STAGE(PG8_SA(0, 0), cA, voffA); PG8_STAGE(PG8_SB(0, 1), cB + hstep, voffB); PG8_STAGE(PG8_SA(0, 1), cA + hstep, voffA);
        if (wr == 1) PG8_BAR;
        PG8_WAIT_V(4); PG8_BAR;
        PG8_STAGE(PG8_SB(1, 0), cB + kstep, voffB); PG8_STAGE(PG8_SA(1, 0), cA + kstep, voffA); PG8_STAGE(PG8_SB(1, 1), cB + hstep + kstep, voffB);
        PG8_WAIT_V(6); PG8_BAR;
    }
    for (;;) {
        const bool has_next = S.next(ui + 1, nxt); const bool full = HALF_OK ? (cur.nrows > 128) : true;
        const char* nA = has_next ? (const char*)g.A + (size_t)nxt.a128 * hstep : cA; const char* nB = has_next ? (const char*)g.Bt + (size_t)nxt.pn * tstep : cB;
        if (!HALF_OK || full) {
        for (int t = 0; t < nt; t += 2) {
            const bool last = (t == nt - 2);
            const char* a1 = cA + (size_t)(t + 1) * kstep;
            const char* a2 = last ? nA : cA + (size_t)(t + 2) * kstep; const char* b2 = last ? nB : cB + (size_t)(t + 2) * kstep;
            const char* a3 = a2 + kstep; const char* b3 = b2 + kstep;
            if (last && has_next) S.a_ready(nxt);
            if constexpr (SP2) {
            PG8_LDB(B0, 0, 0); PG8_LDB(B1, 0, 1); PG8_SCHED; PG8_LDA(At, 0, 0); PG8_STAGE(PG8_SA(1, 1), a1 + hstep, voffA);
            PG8_WAIT_V(8); PG8_WAIT_L(0); PG8_BAR; PG8_MMA(0, 0, At, B0); PG8_MMA(0, 1, At, B1); PG8_BAR; PG8_SCHED;
            PG8_LDA(At, 0, 1); PG8_STAGE(PG8_SB(0, 0), b2, voffB); PG8_STAGE(PG8_SB(0, 1), b2 + hstep, voffB); PG8_STAGE(PG8_SA(0, 0), a2, voffA);
            PG8_WAIT_V(8); PG8_WAIT_L(0); PG8_BAR; if (true) { PG8_MMA(1, 0, At, B0); PG8_MMA(1, 1, At, B1); } PG8_BAR; PG8_SCHED;
            PG8_LDB(B0, 1, 0); PG8_LDB(B1, 1, 1); PG8_SCHED; PG8_LDA(At, 1, 0); PG8_STAGE(PG8_SA(0, 1), a2 + hstep, voffA);
            PG8_WAIT_V(8); PG8_WAIT_L(0); PG8_BAR; PG8_MMA(0, 0, At, B0); PG8_MMA(0, 1, At, B1); PG8_BAR; PG8_SCHED;
            PG8_LDA(At, 1, 1); PG8_STAGE(PG8_SB(1, 0), b3, voffB); PG8_STAGE(PG8_SB(1, 1), b3 + hstep, voffB); PG8_STAGE(PG8_SA(1, 0), a3, voffA);
            PG8_WAIT_V(8); PG8_WAIT_L(0); PG8_BAR; if (true) { PG8_MMA(1, 0, At, B0); PG8_MMA(1, 1, At, B1); } PG8_BAR; PG8_SCHED;
            } else {
            PG8_LDB(B0, 0, 0); PG8_SCHED; PG8_LDA(At, 0, 0); PG8_STAGE(PG8_SA(1, 1), a1 + hstep, voffA);
            PG8_WAIT_L(8); PG8_BAR; PG8_WAIT_L(0); PG8_MMA(0, 0, At, B0); PG8_BAR; PG8_SCHED;
            PG8_LDB(B1, 0, 1); PG8_STAGE(PG8_SB(0, 0), b2, voffB);
            PG8_BAR; PG8_WAIT_L(0); PG8_MMA(0, 1, At, B1); PG8_BAR;
            PG8_LDA(At, 0, 1); PG8_STAGE(PG8_SA(0, 0), a2, voffA);
            PG8_BAR; PG8_WAIT_L(0); if (true) PG8_MMA(1, 0, At, B0); PG8_BAR; PG8_SCHED;
            PG8_STAGE(PG8_SB(0, 1), b2 + hstep, voffB);
            PG8_WAIT_V(6); PG8_BAR; if (true) PG8_MMA(1, 1, At, B1); PG8_BAR;
            PG8_LDB(B0, 1, 0); PG8_SCHED; PG8_LDA(At, 1, 0); PG8_STAGE(PG8_SA(0, 1), a2 + hstep, voffA);
            PG8_WAIT_L(8); PG8_BAR; PG8_WAIT_L(0); PG8_MMA(0, 0, At, B0); PG8_BAR; PG8_SCHED;
            PG8_LDB(B1, 1, 1); PG8_STAGE(PG8_SB(1, 0), b3, voffB);
            PG8_BAR; PG8_WAIT_L(0); PG8_MMA(0, 1, At, B1); PG8_BAR;
            PG8_LDA(At, 1, 1); PG8_STAGE(PG8_SA(1, 0), a3, voffA);
            PG8_BAR; PG8_WAIT_L(0); if (true) PG8_MMA(1, 0, At, B0); PG8_BAR; PG8_SCHED;
            PG8_STAGE(PG8_SB(1, 1), b3 + hstep, voffB);
            PG8_WAIT_V(6); PG8_BAR; if (true) PG8_MMA(1, 1, At, B1); PG8_BAR;
            }
        }
        } else {
        for (int t = 0; t < nt; t += 2) {
            const bool last = (t == nt - 2);
            const char* a1 = cA + (size_t)(t + 1) * kstep;
            const char* a2 = last ? nA : cA + (size_t)(t + 2) * kstep; const char* b2 = last ? nB : cB + (size_t)(t + 2) * kstep;
            const char* a3 = a2 + kstep; const char* b3 = b2 + kstep;
            if (last && has_next) S.a_ready(nxt);
            if constexpr (SP2) {
            PG8_LDB(B0, 0, 0); PG8_LDB(B1, 0, 1); PG8_SCHED; PG8_LDA(At, 0, 0); PG8_STAGE(PG8_SA(1, 1), a1 + hstep, voffA);
            PG8_WAIT_V(8); PG8_WAIT_L(0); PG8_BAR; PG8_MMA(0, 0, At, B0); PG8_MMA(0, 1, At, B1); PG8_BAR; PG8_SCHED;
            PG8_LDA(At, 0, 1); PG8_STAGE(PG8_SB(0, 0), b2, voffB); PG8_STAGE(PG8_SB(0, 1), b2 + hstep, voffB); PG8_STAGE(PG8_SA(0, 0), a2, voffA);
            PG8_WAIT_V(8); PG8_WAIT_L(0); PG8_BAR; if (false) { PG8_MMA(1, 0, At, B0); PG8_MMA(1, 1, At, B1); } PG8_BAR; PG8_SCHED;
            PG8_LDB(B0, 1, 0); PG8_LDB(B1, 1, 1); PG8_SCHED; PG8_LDA(At, 1, 0); PG8_STAGE(PG8_SA(0, 1), a2 + hstep, voffA);
            PG8_WAIT_V(8); PG8_WAIT_L(0); PG8_BAR; PG8_MMA(0, 0, At, B0); PG8_MMA(0, 1, At, B1); PG8_BAR; PG8_SCHED;
            PG8_LDA(At, 1, 1); PG8_STAGE(PG8_SB(1, 0), b3, voffB); PG8_STAGE(PG8_SB(1, 1), b3 + hstep, voffB); PG8_STAGE(PG8_SA(1, 0), a3, voffA);
            PG8_WAIT_V(8); PG8_WAIT_L(0); PG8_BAR; if (false) { PG8_MMA(1, 0, At, B0); PG8_MMA(1, 1, At, B1); } PG8_BAR; PG8_SCHED;
            } else {
            PG8_LDB(B0, 0, 0); PG8_SCHED; PG8_LDA(At, 0, 0); PG8_STAGE(PG8_SA(1, 1), a1 + hstep, voffA);
            PG8_WAIT_L(8); PG8_BAR; PG8_WAIT_L(0); PG8_MMA(0, 0, At, B0); PG8_BAR; PG8_SCHED;
            PG8_LDB(B1, 0, 1); PG8_STAGE(PG8_SB(0, 0), b2, voffB);
            PG8_BAR; PG8_WAIT_L(0); PG8_MMA(0, 1, At, B1); PG8_BAR;
            PG8_LDA(At, 0, 1); PG8_STAGE(PG8_SA(0, 0), a2, voffA);
            PG8_BAR; PG8_WAIT_L(0); if (false) PG8_MMA(1, 0, At, B0); PG8_BAR; PG8_SCHED;
            PG8_STAGE(PG8_SB(0, 1), b2 + hstep, voffB);
            PG8_WAIT_V(6); PG8_BAR; if (false) PG8_MMA(1, 1, At, B1); PG8_BAR;
            PG8_LDB(B0, 1, 0); PG8_SCHED; PG8_LDA(At, 1, 0); PG8_STAGE(PG8_SA(0, 1), a2 + hstep, voffA);
            PG8_WAIT_L(8); PG8_BAR; PG8_WAIT_L(0); PG8_MMA(0, 0, At, B0); PG8_BAR; PG8_SCHED;
            PG8_LDB(B1, 1, 1); PG8_STAGE(PG8_SB(1, 0), b3, voffB);
            PG8_BAR; PG8_WAIT_L(0); PG8_MMA(0, 1, At, B1); PG8_BAR;
            PG8_LDA(At, 1, 1); PG8_STAGE(PG8_SA(1, 0), a3, voffA);
            PG8_BAR; PG8_WAIT_L(0); if (false) PG8_MMA(1, 0, At, B0); PG8_BAR; PG8_SCHED;
            PG8_STAGE(PG8_SB(1, 1), b3 + hstep, voffB);
            PG8_WAIT_V(6); PG8_BAR; if (false) PG8_MMA(1, 1, At, B1); PG8_BAR;
            }
        }
        }
        if constexpr (ALIGN_EPI) { if (wr == 0) PG8_BAR; }
        if constexpr (!Epi::AFTER_DRAIN) { int t2_ = lane_id(); asm volatile("" : "+v"(t2_)); E(acc, cur, wr, wc, t2_ & 15, t2_ >> 4); S.done(cur); }
        if (!has_next) break;
#pragma unroll
        for (int a = 0; a < 2; ++a)
#pragma unroll
            for (int b = 0; b < 2; ++b)
#pragma unroll
                for (int m = 0; m < 4; ++m)
#pragma unroll
                    for (int n = 0; n < 2; ++n) acc[a][b][m][n] = (f32x4){0.f, 0.f, 0.f, 0.f};
        cur = nxt; cA = nA; cB = nB; ++ui;
        if constexpr (ALIGN_EPI) { if (wr == 1) PG8_BAR; }
    }
    PG8_WAIT_V(0);
    if constexpr (!ALIGN_EPI) { if (wr == 0) PG8_BAR; }
    PG8_BAR;
    if constexpr (Epi::AFTER_DRAIN) { E.fused(acc, cur, wr, wc, fr, fq, lds, wid, lane); S.done(cur); }
#undef PG8_SA
#undef PG8_SB
#undef PG8_STAGE
#undef PG8_LDA
#undef PG8_LDB
#undef PG8_MMA
#undef PG8_WAIT_V
#undef PG8_WAIT_L
#undef PG8_BAR
#undef PG8_SCHED
}
}
#define XB_TMO      128
#define XB_XCNT(j)  (256  + 64 * (j))
#define XB_XSUB(j)  (1280 + 64 * (j))
#define XB_XGEN(j)  (2304 + 64 * (j))
#define XB_TOP      3328
#define XB_TOPGEN   3392
#define XCD_BAR_WORDS 3456
#define XB_SPIN_CAP (1u << 18)

__device__ __forceinline__ unsigned xb_ld(unsigned* p)              { return __hip_atomic_load(p, __ATOMIC_RELAXED, __HIP_MEMORY_SCOPE_AGENT); }
__device__ __forceinline__ unsigned xb_add(unsigned* p, unsigned v) { return __hip_atomic_fetch_add(p, v, __ATOMIC_RELAXED, __HIP_MEMORY_SCOPE_AGENT); }
__device__ __forceinline__ unsigned xb_xcc_id() { return (unsigned)__builtin_amdgcn_s_getreg((3 << 11) | 20) & 0xFu; }
#define XB_SPIN(cond, bar) do { unsigned _sp = 0; while (cond) { __builtin_amdgcn_s_sleep(1); \
    if ((++_sp & 255u) == 0u) { if (xb_ld(&(bar)[XB_TMO])) break; if (_sp > XB_SPIN_CAP) { atomicAdd(&(bar)[XB_TMO], 1u); break; } } } } while (0)

struct XcdBarrier {
    unsigned* bar; unsigned x;
    volatile LAS unsigned* st;
};

__device__ __forceinline__ XcdBarrier xcd_barrier_post(unsigned* bar, volatile LAS unsigned* st) {
    XcdBarrier b; b.bar = bar; b.x = xb_xcc_id(); b.st = st;
    if (threadIdx.x == 0) (void)xb_add(&bar[XB_XCNT(b.x)], 1u);
    return b;
}
__device__ __forceinline__ void xcd_barrier_complete(unsigned* bar, unsigned x, unsigned& nloc, unsigned& nx) {
    const unsigned G = gridDim.x * gridDim.y * gridDim.z;
    unsigned sum, cnt, mine, sp = 0u;
    for (;;) {
        sum = 0u; cnt = 0u; mine = 0u;
#pragma unroll
        for (unsigned j = 0; j < 16; ++j) { const unsigned c = xb_ld(&bar[XB_XCNT(j)]); sum += c; cnt += (c > 0u) ? 1u : 0u; mine = (j == x) ? c : mine; }
        if (sum == G) break;
        __builtin_amdgcn_s_sleep(1);
        if ((++sp & 255u) == 0u) { if (xb_ld(&bar[XB_TMO])) break; if (sp > XB_SPIN_CAP) { atomicAdd(&bar[XB_TMO], 1u); break; } }
    }
    nloc = mine > 0u ? mine : 1u; nx = cnt > 0u ? cnt : 1u;
}

__device__ __forceinline__ void xcd_barrier(const XcdBarrier& b) {
    asm volatile("s_waitcnt vmcnt(0)" ::: "memory");
    __syncthreads();
    if (threadIdx.x == 0) {
        unsigned* bar = b.bar;
        __builtin_amdgcn_s_waitcnt(0);
        unsigned nloc = b.st[0], nx = b.st[1];
        if (nloc == 0u) { xcd_barrier_complete(bar, b.x, nloc, nx); b.st[0] = nloc; b.st[1] = nx; }
        const unsigned old = xb_add(&bar[XB_XSUB(b.x)], 1u);
        const unsigned gen = old / nloc;
        if (old + 1u == (gen + 1u) * nloc) {
            __builtin_amdgcn_fence(__ATOMIC_RELEASE, "agent");
            asm volatile("s_waitcnt vmcnt(0)" ::: "memory");
            const unsigned og = xb_add(&bar[XB_TOP], 1u);
            const unsigned tg = og / nx;
            if (og + 1u == (tg + 1u) * nx) xb_add(&bar[XB_TOPGEN], 1u);
            else XB_SPIN(xb_ld(&bar[XB_TOPGEN]) == tg, bar);
            __builtin_amdgcn_fence(__ATOMIC_ACQUIRE, "agent");
            xb_add(&bar[XB_XGEN(b.x)], 1u);
            asm volatile("s_waitcnt vmcnt(0)" ::: "memory");
        } else {
            XB_SPIN(xb_ld(&bar[XB_XGEN(b.x)]) == gen, bar);
            __builtin_amdgcn_fence(__ATOMIC_ACQUIRE, "agent");
            asm volatile("s_waitcnt vmcnt(0)" ::: "memory");
        }
    }
    __syncthreads();
}
constexpr int NWAVES = 8;
constexpr int NB = 2, SEQ = 4096, T = NB * SEQ, D = 2048;
constexpr int W_IN_LD = 6168, PROJ_N = 6144;
constexpr int PJ_GQ = 0, PJ_GK = 512, PJ_GV = 1024, PJ_GR = 2048, PJ_FQ = 3072, PJ_FK = 4096, PJ_FV = 5120;
constexpr int WIN_GA = 3072, WIN_FF = 6160;
constexpr int GLA_H = 4, GLA_DK = 128, GLA_DV = 256, FOX_H = 8, FOX_DH = 128;
constexpr int MEM_LEN = 256, XH = 4, XDH = 512;
constexpr int NE = 32, TOPK = 4, DFF = 2048;
constexpr int XS_ROWS = 37120;
constexpr float EPS = 1e-6f;
constexpr int LDP = D + 64;
constexpr float W8_SCALE = 256.f, X8_SCALE = 8.f, H8_SCALE = 4.f, O8_SCALE = 16.f, Y8_SCALE = 16.f;
#ifndef MK_N_LAUNCHES
#define MK_N_LAUNCHES 1
#endif
constexpr int N_PHASES = 14;
#ifndef PROBE_REP
#define PROBE_REP (-1)
#endif

constexpr size_t al256(size_t x) { return (x + 255) & ~(size_t)255; }
constexpr size_t WS_CTL = 0, CTL_ZERO_BYTES = 1u << 20;
constexpr size_t WS_WT_IN  = CTL_ZERO_BYTES;
constexpr size_t WS_WT_OUT = WS_WT_IN  + (size_t)PROJ_N * D * 2;
constexpr size_t WS_WT_XQ  = WS_WT_OUT + (size_t)D * LDP * 2;
constexpr size_t WS_WT_XKV = WS_WT_XQ  + (size_t)D * D * 2;
constexpr size_t WS_WT_XO  = WS_WT_XKV + (size_t)2 * D * D * 2;
constexpr size_t WS_WT_GU  = WS_WT_XO  + (size_t)D * D * 2;
constexpr size_t WS_WT_DN  = WS_WT_GU  + (size_t)NE * 2 * DFF * D * 2;
constexpr size_t WS_XN     = WS_WT_DN  + (size_t)NE * D * DFF * 2;
constexpr size_t WS_PROJ   = WS_XN     + (size_t)T * D * 2;
constexpr size_t WS_GA     = WS_PROJ   + (size_t)T * PROJ_N * 2;
constexpr size_t WS_LF     = WS_GA     + (size_t)T * 16 * 4;
constexpr size_t WS_CF     = WS_LF     + (size_t)T * 8 * 4;
constexpr size_t WS_MEMN   = WS_CF     + (size_t)16 * SEQ * 4;
constexpr size_t WS_KV2    = WS_MEMN   + (size_t)NB * MEM_LEN * D * 2;
constexpr size_t WS_OG     = WS_KV2    + (size_t)NB * MEM_LEN * 2 * D * 2;
constexpr size_t WS_CAT    = WS_OG     + (size_t)T * 1024 * 4;
constexpr size_t WS_H1     = WS_CAT    + (size_t)T * LDP * 2;
constexpr size_t WS_H2     = WS_H1     + (size_t)T * D * 4;
constexpr size_t WS_Q2     = WS_H2     + (size_t)T * D * 4;
constexpr size_t WS_XO     = WS_Q2     + (size_t)T * D * 2;
constexpr size_t WS_TOPE   = WS_XO     + (size_t)T * D * 2;
constexpr size_t WS_TOPG   = WS_TOPE   + (size_t)T * 4 * 4;
constexpr size_t WS_CNT    = WS_TOPG   + (size_t)T * 4 * 4;
constexpr size_t WS_TSLOT  = WS_CNT    + (size_t)256 * 32 * 4;
constexpr size_t WS_RT     = WS_TSLOT  + (size_t)T * 4 * 4;
constexpr size_t WS_UL     = al256(WS_RT + 8192);
constexpr size_t WS_SSP    = WS_UL + 131072;
constexpr size_t WS_XS     = WS_SSP + (size_t)T * 32 * 4;
constexpr size_t WS_HH     = WS_XS     + (size_t)XS_ROWS * D * 2;
constexpr size_t WS_YY     = WS_HH     + (size_t)XS_ROWS * D * 2;
constexpr size_t WS_END    = WS_YY     + (size_t)XS_ROWS * D * 2;
constexpr int CW_TMO = 0, CW_BAR = 4096, CW_KMAX = 2048;

constexpr int RING_OFF = 0, RING_BYTES = 131072;
constexpr int LDSCTL_OFF = 139264, MISC_OFF = LDSCTL_OFF + 320;
constexpr int LDS_BYTES = 147456;


typedef unsigned short bf16;
typedef unsigned v4u __attribute__((ext_vector_type(4)));
typedef unsigned v2u __attribute__((ext_vector_type(2)));
typedef float f32x4 __attribute__((ext_vector_type(4)));
typedef short bf16x8 __attribute__((ext_vector_type(8)));
typedef float f32x16 __attribute__((ext_vector_type(16)));
#define LDS_WAIT() asm volatile("s_waitcnt lgkmcnt(0)" ::: "memory")
#define VM_WAIT() asm volatile("s_waitcnt vmcnt(0)" ::: "memory")
__device__ __forceinline__ unsigned f2bf(float f) { unsigned u = __builtin_bit_cast(unsigned, f); return (u + 0x7fffu + ((u >> 16) & 1u)) >> 16; }
__device__ __forceinline__ unsigned pk2(float lo, float hi) { return f2bf(lo) | (f2bf(hi) << 16); }
__device__ __forceinline__ float bf2f(unsigned short b) { return __builtin_bit_cast(float, (unsigned)b << 16); }
__device__ __forceinline__ float bflo(unsigned w) { return __builtin_bit_cast(float, w << 16); }
__device__ __forceinline__ float bfhi(unsigned w) { return __builtin_bit_cast(float, w & 0xffff0000u); }
struct Args { const float* in[22]; float* out; unsigned char* ws; int ph_lo, ph_hi; };
struct Ctx { LAS unsigned char* lds; unsigned char* ws; int tid, lane, wave, G, bid, gw, ngw; };
enum { I_X = 0, I_MEM, I_NORM_MIX, I_W_IN, I_W_ALPHA, I_B_ALPHA, I_B_FGATE, I_GLA_NORM, I_W_OUT, I_NORM_XATTN, I_NORM_MEM, I_W_XQ, I_W_XKV, I_W_XO,
       I_NORM_MOE, I_W_ROUTER, I_B_ROUTER, I_W_GU, I_B_GU, I_W_DN, I_B_DN, I_NORM_FINAL };

__device__ __forceinline__ float wave_sum(float v) {
#pragma unroll
    for (int o = 1; o < 64; o <<= 1) v += __shfl_xor(v, o);
    return v;
}
__device__ __forceinline__ float wave_max(float v) {
#pragma unroll
    for (int o = 1; o < 64; o <<= 1) v = fmaxf(v, __shfl_xor(v, o));
    return v;
}
__device__ __forceinline__ float log_sigmoid(float x) { return fminf(x, 0.f) - log1pf(__expf(-fabsf(x))); }
__device__ __forceinline__ float silu(float x) { return x / (1.f + __expf(-x)); }

__device__ __forceinline__ void rms_row_to_bf16(const float* xrow, const float* g, bf16* orow, int lane) {
    const f32x4* xr = (const f32x4*)xrow + lane; const f32x4* gr = (const f32x4*)g + lane;
    f32x4 v[8]; float s = 0.f;
#pragma unroll
    for (int j = 0; j < 8; ++j) { v[j] = xr[64 * j]; s += (v[j].x * v[j].x + v[j].y * v[j].y) + (v[j].z * v[j].z + v[j].w * v[j].w); }
    const float rstd = rsqrtf(wave_sum(s) * (1.f / D) + EPS);
    unsigned long long* o8 = (unsigned long long*)orow + lane;
#pragma unroll
    for (int j = 0; j < 8; ++j) { const f32x4 gg = gr[64 * j]; const f32x4 y = v[j] * rstd * gg;
        o8[64 * j] = (unsigned long long)pk2(y.x, y.y) | ((unsigned long long)pk2(y.z, y.w) << 32); }
}

__device__ __forceinline__ void conv_decode(const Args& A, unsigned char* ws, int it, const float*& src, int& ld, unsigned char*& dst) {
    if (it < 65536) { const int e = it >> 11, kb = (it >> 7) & 15, nb = it & 127; ld = 2 * DFF;
        src = A.in[I_W_GU] + ((size_t)e * D + 128 * kb) * (2 * DFF) + 32 * nb; dst = ws + WS_WT_GU + ((size_t)e * 2 * DFF + 32 * nb) * D + 128 * kb; }
    else { it -= 65536; const int e = it >> 10, kb = (it >> 6) & 15, nb = it & 63; ld = D;
        src = A.in[I_W_DN] + ((size_t)e * DFF + 128 * kb) * D + 32 * nb; dst = ws + WS_WT_DN + ((size_t)e * D + 32 * nb) * DFF + 128 * kb; }
}
#define CONV_LOAD(buf, jj) do { conv_decode(A, C.ws, (jj) * C.ngw + C.gw, src_##buf, ld_##buf, dst_##buf); \
        _Pragma("unroll") for (int i_ = 0; i_ < 16; ++i_) buf[i_] = __builtin_nontemporal_load((const f32x4*)(src_##buf + (size_t)(8 * i_ + lr) * ld_##buf + lc)); } while (0)
#define CONV_PROC(buf, jn, MORE) do { unsigned char* dcur_ = dst_##buf; \
        if (MORE) conv_decode(A, C.ws, (jn) * C.ngw + C.gw, src_##buf, ld_##buf, dst_##buf); \
        _Pragma("unroll") for (int i_ = 0; i_ < 16; ++i_) { LAS float* p_ = scr + (8 * i_ + lr) * 33 + lc; const f32x4 v_ = buf[i_] * W8_SCALE; p_[0] = v_.x; p_[1] = v_.y; p_[2] = v_.z; p_[3] = v_.w; \
            if (MORE) buf[i_] = __builtin_nontemporal_load((const f32x4*)(src_##buf + (size_t)(8 * i_ + lr) * ld_##buf + lc)); } \
        LDS_WAIT(); asm volatile("" ::: "memory"); \
        _Pragma("unroll") for (int h_ = 0; h_ < 4; ++h_) { const int n_ = (lane >> 3) + 8 * h_; const LAS float* s_ = scr + (16 * (lane & 7)) * 33 + n_; int w_[4]; \
            _Pragma("unroll") for (int q_ = 0; q_ < 4; ++q_) { int t_ = 0; t_ = __builtin_amdgcn_cvt_pk_fp8_f32(s_[(4 * q_) * 33], s_[(4 * q_ + 1) * 33], t_, false); t_ = __builtin_amdgcn_cvt_pk_fp8_f32(s_[(4 * q_ + 2) * 33], s_[(4 * q_ + 3) * 33], t_, true); w_[q_] = t_; } \
            *(GAS v4u*)(dcur_ + (size_t)n_ * 2048 + 16 * (lane & 7)) = (v4u){(unsigned)w_[0], (unsigned)w_[1], (unsigned)w_[2], (unsigned)w_[3]}; } \
        LDS_WAIT(); asm volatile("" ::: "memory"); } while (0)
__device__ __forceinline__ void conv_items_f8(const Ctx& C, const Args& A, int j_lo, int j_hi) {
    LAS float* scr = (LAS float*)(C.lds + RING_OFF + C.wave * 16896);
    const int lane = lane_id(), lr = lane >> 3, lc = 4 * (lane & 7);
    const float *src_b0, *src_b1; int ld_b0, ld_b1; unsigned char *dst_b0, *dst_b1;
    f32x4 b0[16], b1[16];
    CONV_LOAD(b0, j_lo); CONV_LOAD(b1, j_lo + 1);
#pragma unroll 1
    for (int j = j_lo; j + 2 < j_hi; j += 2) { CONV_PROC(b0, j + 2, 1); CONV_PROC(b1, j + 3, 1); }
    CONV_PROC(b0, 0, 0); CONV_PROC(b1, 0, 0);
}
#undef CONV_LOAD
#undef CONV_PROC
__device__ __forceinline__ void convd_decode(const Args& A, unsigned char* ws, int it, const float*& src, int& ld, unsigned char*& dst, int& f8, int& dld) {
    dld = D;
    if (it < 3072) { const int half = it / 1536, r = it % 1536, kb = r / 96, nb = r % 96; ld = W_IN_LD; f8 = 0;
        src = A.in[I_W_IN] + (size_t)(128 * kb) * W_IN_LD + (half ? 3088 : 0) + 32 * nb; dst = ws + WS_WT_IN + ((size_t)(half * 3072 + 32 * nb) * D + 128 * kb) * 2; }
    else if (it < 4096) { const int r = it - 3072, kb = r >> 6, nb = r & 63; ld = D; f8 = 0; dld = LDP; src = A.in[I_W_OUT] + (size_t)(128 * kb) * D + 32 * nb; dst = ws + WS_WT_OUT + ((size_t)(32 * nb) * LDP + 128 * kb) * 2; }
    else if (it < 6144) { const int r = it - 4096, kb = r >> 7, nb = r & 127; ld = 2 * D; f8 = 0; src = A.in[I_W_XKV] + (size_t)(128 * kb) * (2 * D) + 32 * nb; dst = ws + WS_WT_XKV + ((size_t)(32 * nb) * D + 128 * kb) * 2; }
    else if (it < 7168) { const int r = it - 6144, kb = r >> 6, nb = r & 63; ld = D; f8 = 1; src = A.in[I_W_XQ] + (size_t)(128 * kb) * D + 32 * nb; dst = ws + WS_WT_XQ + (size_t)(32 * nb) * D + 128 * kb; }
    else { const int r = it - 7168, kb = r >> 6, nb = r & 63; ld = D; f8 = 1; src = A.in[I_W_XO] + (size_t)(128 * kb) * D + 32 * nb; dst = ws + WS_WT_XO + (size_t)(32 * nb) * D + 128 * kb; }
}
__device__ __forceinline__ void conv_dense(const Ctx& C, const Args& A, const int it_lo, const int it_hi) {
    LAS float* scr = (LAS float*)(C.lds + RING_OFF + C.wave * 16896);
    const int lane = lane_id(), lr = lane >> 3, lc = 4 * (lane & 7);
    const int NIT = it_hi;
    const float* src; int ld, f8, f8n, dld, dldn; unsigned char *dst, *dnx;
    if (it_lo + C.gw >= NIT) return;
    f32x4 cur[16], nxt[16];
    convd_decode(A, C.ws, it_lo + C.gw, src, ld, dst, f8, dld);
#pragma unroll
    for (int i = 0; i < 16; ++i) cur[i] = __builtin_nontemporal_load((const f32x4*)(src + (size_t)(8 * i + lr) * ld + lc));
#pragma unroll 1
    for (int it = it_lo + C.gw; it < NIT; it += C.ngw) {
        const bool more = it + C.ngw < NIT;
        if (more) { convd_decode(A, C.ws, it + C.ngw, src, ld, dnx, f8n, dldn);
#pragma unroll
            for (int i = 0; i < 16; ++i) nxt[i] = __builtin_nontemporal_load((const f32x4*)(src + (size_t)(8 * i + lr) * ld + lc)); }
        const float sc = f8 ? W8_SCALE : 1.f;
#pragma unroll
        for (int i = 0; i < 16; ++i) { LAS float* p = scr + (8 * i + lr) * 33 + lc; const f32x4 v = cur[i] * sc; p[0] = v.x; p[1] = v.y; p[2] = v.z; p[3] = v.w; }
        LDS_WAIT(); asm volatile("" ::: "memory");
        const int c = lane & 7;
#pragma unroll
        for (int h = 0; h < 4; ++h) { const int n = (lane >> 3) + 8 * h; const LAS float* s = scr + (16 * c) * 33 + n;
            if (f8) { int w[4];
#pragma unroll
                for (int q = 0; q < 4; ++q) { int t = 0; t = __builtin_amdgcn_cvt_pk_fp8_f32(s[(4 * q) * 33], s[(4 * q + 1) * 33], t, false); t = __builtin_amdgcn_cvt_pk_fp8_f32(s[(4 * q + 2) * 33], s[(4 * q + 3) * 33], t, true); w[q] = t; }
                *(GAS v4u*)(dst + (size_t)n * dld + 16 * c) = (v4u){(unsigned)w[0], (unsigned)w[1], (unsigned)w[2], (unsigned)w[3]}; }
            else { unsigned w[8];
#pragma unroll
                for (int q = 0; q < 8; ++q) w[q] = pk2(s[(2 * q) * 33], s[(2 * q + 1) * 33]);
                *(GAS v4u*)(dst + ((size_t)n * dld + 16 * c) * 2) = (v4u){w[0], w[1], w[2], w[3]}; *(GAS v4u*)(dst + ((size_t)n * dld + 16 * c) * 2 + 16) = (v4u){w[4], w[5], w[6], w[7]}; } }
        LDS_WAIT(); asm volatile("" ::: "memory");
        if (more) {
#pragma unroll
            for (int i = 0; i < 16; ++i) cur[i] = nxt[i];
            dst = dnx; f8 = f8n; dld = dldn; }
    }
}
template <int MODE> __device__ __forceinline__ void rows32_proj(const Ctx& C, int blk, const float* SRC, const float* nm, const float* W, int ldw, int wofs, void* OUT) {
    LAS float* RS = (LAS float*)(C.lds + 256); LAS float* PART = (LAS float*)(C.lds + 1024); LAS float* LG = (LAS float*)(C.lds + 1024 + 32768);
    const int lane = C.lane, tl = lane & 31, kk = lane >> 5;
    { f32x4 v[4][8];
#pragma unroll
      for (int q = 0; q < 4; ++q) { const f32x4* xr = (const f32x4*)(SRC + (size_t)(blk * 32 + C.wave * 4 + q) * D) + lane;
#pragma unroll
          for (int j = 0; j < 8; ++j) v[q][j] = xr[64 * j]; }
      const f32x4* gr = (const f32x4*)nm + lane;
#pragma unroll
      for (int q = 0; q < 4; ++q) { const int t = blk * 32 + C.wave * 4 + q; float s = 0.f;
#pragma unroll
        for (int j = 0; j < 8; ++j) s += (v[q][j].x * v[q][j].x + v[q][j].y * v[q][j].y) + (v[q][j].z * v[q][j].z + v[q][j].w * v[q][j].w);
        const float rstd = rsqrtf(wave_sum(s) * (1.f / D) + EPS);
        if constexpr (MODE == 0) { unsigned long long* o8 = (unsigned long long*)((bf16*)OUT + (size_t)t * D) + lane;
#pragma unroll
            for (int j = 0; j < 8; ++j) { const f32x4 gg = gr[64 * j]; const f32x4 y = v[q][j] * rstd * gg;
                o8[64 * j] = (unsigned long long)pk2(y.x, y.y) | ((unsigned long long)pk2(y.z, y.w) << 32); } }
        else { int* o4 = (int*)((unsigned char*)OUT + (size_t)t * D) + lane;
#pragma unroll
            for (int j = 0; j < 8; ++j) { const f32x4 gg = gr[64 * j]; const f32x4 y = v[q][j] * (rstd * X8_SCALE) * gg;
                int w = 0; w = __builtin_amdgcn_cvt_pk_fp8_f32(y.x, y.y, w, false); w = __builtin_amdgcn_cvt_pk_fp8_f32(y.z, y.w, w, true); o4[64 * j] = w; } }
        if (lane == 0) RS[C.wave * 4 + q] = rstd; } }
    f32x16 acc;
#pragma unroll
    for (int e = 0; e < 16; ++e) acc[e] = 0.f;
    const float* xrow = SRC + (size_t)(blk * 32 + tl) * D + 256 * C.wave + 4 * kk;
    const float* grow = nm + 256 * C.wave + 4 * kk; const float* wcol = W + (size_t)(256 * C.wave + 4 * kk) * ldw + wofs;
#pragma unroll 8
    for (int m = 0; m < 32; ++m) { const f32x4 x4 = *(const f32x4*)(xrow + 8 * m), g4 = *(const f32x4*)(grow + 8 * m);
        const float w0 = wcol[(size_t)(8 * m) * ldw], w1 = wcol[(size_t)(8 * m + 1) * ldw], w2 = wcol[(size_t)(8 * m + 2) * ldw], w3 = wcol[(size_t)(8 * m + 3) * ldw];
        acc = __builtin_amdgcn_mfma_f32_32x32x2f32(x4.x * g4.x, w0, acc, 0, 0, 0); acc = __builtin_amdgcn_mfma_f32_32x32x2f32(x4.y * g4.y, w1, acc, 0, 0, 0);
        acc = __builtin_amdgcn_mfma_f32_32x32x2f32(x4.z * g4.z, w2, acc, 0, 0, 0); acc = __builtin_amdgcn_mfma_f32_32x32x2f32(x4.w * g4.w, w3, acc, 0, 0, 0); }
#pragma unroll
    for (int e = 0; e < 16; ++e) PART[(C.wave * 16 + e) * 64 + lane] = acc[e];
    __syncthreads();
#pragma unroll
    for (int rep = 0; rep < 2; ++rep) { const int idx = C.tid + 512 * rep, reg = idx >> 6, ln = idx & 63; float s = 0.f;
#pragma unroll
        for (int w = 0; w < 8; ++w) s += PART[(w * 16 + reg) * 64 + ln];
        const int t = (reg & 3) + 8 * (reg >> 2) + 4 * (ln >> 5), e = ln & 31;
        LG[t * 33 + e] = s * RS[t]; }
    __syncthreads();
}
__device__ __forceinline__ void p0_prologue(const Ctx& C, const Args& A) {
    unsigned char* ws = C.ws;
    conv_dense(C, A, 0, 3072);
    { float* GA = (float*)(ws + WS_GA); float* LF = (float*)(ws + WS_LF); const LAS float* LG = (const LAS float*)(C.lds + 1024 + 32768);
      const int tl = C.lane & 31; const int wofs = tl < 16 ? WIN_GA + tl : (tl < 24 ? WIN_FF + tl - 16 : WIN_GA);
      for (int blk = C.bid; blk < T / 32; blk += C.G) {
          __syncthreads();
          rows32_proj<0>(C, blk, A.in[I_X], A.in[I_NORM_MIX], A.in[I_W_IN], W_IN_LD, wofs, ws + WS_XN);
          { const int t = C.tid >> 4, j = C.tid & 15; GA[(size_t)(blk * 32 + t) * 16 + j] = LG[t * 33 + j]; }
          if (C.tid < 256) { const int t = C.tid >> 3, h = C.tid & 7; LF[(size_t)(blk * 32 + t) * 8 + h] = log_sigmoid(LG[t * 33 + 16 + h] + A.in[I_B_FGATE][h]); }
      } }
    for (int m = C.gw; m < NB * MEM_LEN; m += C.ngw) rms_row_to_bf16(A.in[I_MEM] + (size_t)m * D, A.in[I_NORM_MEM], (bf16*)(ws + WS_MEMN) + (size_t)m * D, C.lane);
}

__device__ __forceinline__ void cumsum_cf(const Ctx& C) {
    if (C.gw >= 16) return;
    const int b = C.gw >> 3, h = C.gw & 7; const float* LF = (const float*)(C.ws + WS_LF); float* CF = (float*)(C.ws + WS_CF) + (size_t)C.gw * SEQ;
    const float* src = LF + ((size_t)b * SEQ + C.lane * 64) * 8 + h;
    float v[64]; float loc = 0.f;
#pragma unroll
    for (int i = 0; i < 64; ++i) v[i] = src[i * 8];
#pragma unroll
    for (int i = 0; i < 64; ++i) loc += v[i];
    float inc = loc;
#pragma unroll
    for (int o = 1; o < 64; o <<= 1) { const float t = __shfl_up(inc, o); if (C.lane >= o) inc += t; }
    float run = inc - loc;
#pragma unroll
    for (int i = 0; i < 64; ++i) { run += v[i]; CF[C.lane * 64 + i] = -run * 1.4426950408889634f; }
}
typedef short s16x4 __attribute__((ext_vector_type(4)));
typedef short v4i16_t __attribute__((ext_vector_type(4)));
typedef float f32x2_t __attribute__((ext_vector_type(2)));
typedef __bf16 bf16x2_t __attribute__((ext_vector_type(2)));
#define MFMA32(a, b, c) __builtin_amdgcn_mfma_f32_32x32x16_bf16((a), (b), (c), 0, 0, 0)
__device__ __forceinline__ s16x4 tr_read(const LAS unsigned char* p) { return __builtin_bit_cast(s16x4, __builtin_amdgcn_ds_read_tr16_b64_v4i16((LAS v4i16_t*)p)); }
__device__ __forceinline__ unsigned cvtpk(float lo, float hi) { f32x2_t v = {lo, hi}; bf16x2_t b = __builtin_convertvector(v, bf16x2_t); return __builtin_bit_cast(unsigned, b); }
__device__ __forceinline__ bf16x8 pack8(const f32x16& x, int s) {
    v4u p; p.x = cvtpk(x[8 * s], x[8 * s + 1]); p.y = cvtpk(x[8 * s + 2], x[8 * s + 3]); p.z = cvtpk(x[8 * s + 4], x[8 * s + 5]); p.w = cvtpk(x[8 * s + 6], x[8 * s + 7]);
    return __builtin_bit_cast(bf16x8, p);
}
__device__ __forceinline__ int fox_vaddr(int k, int c) { return ((k >> 3) * 4 + (c >> 5)) * 512 + (k & 7) * 64 + (c & 31) * 2; }

__device__ __forceinline__ void fox_phase(const Ctx& C) {
    constexpr int FB = 66048;
    LAS float* XCH = (LAS float*)C.lds; volatile LAS int* STOPF = (volatile LAS int*)(C.lds + 2 * FB);
    const bf16* PROJ = (const bf16*)(C.ws + WS_PROJ); bf16* CAT = (bf16*)(C.ws + WS_CAT); const float* CF = (const float*)(C.ws + WS_CF);
    const int lane = C.lane, r = lane & 31, hh = lane >> 5, qi = C.wave & 3, kh = C.wave >> 2;
    const int i16 = lane & 15, blk = (lane >> 4) & 1;
    constexpr float LOG2E = 1.4426950408889634f, C1 = 0.08838834764831845f * LOG2E;
    const unsigned ldsb = (unsigned)(unsigned long long)C.lds;
    const int vlane = (4 * hh + (i16 >> 2)) * 64 + 32 * blk + 8 * (i16 & 3);
    for (int unit = C.bid; unit < 256; unit += C.G) {
        const int bh = unit >> 4, x = unit & 15, b = bh >> 3, h = bh & 7;
        const float kmax2 = __uint_as_float(((const unsigned*)(C.ws + WS_CTL))[CW_KMAX + bh]);
#pragma unroll 1
        for (int pass = 0; pass < 2; ++pass) {
            const int X = pass ? 31 - x : x, q0 = 128 * X;
            const size_t qrow0 = (size_t)b * SEQ + q0 + 32 * qi;
            const char* qbase = (const char*)(PROJ + qrow0 * PROJ_N + PJ_FQ + h * 128);
            const unsigned qlo = (unsigned)((r * PROJ_N + 8 * hh) * 2);
            bf16x8 qf[8];
#pragma unroll
            for (int ks = 0; ks < 8; ++ks) qf[ks] = *(const bf16x8*)(qbase + qlo + 32 * ks);
            float ubq;
            { float qn = 0.f;
#pragma unroll
              for (int ks = 0; ks < 8; ++ks)
#pragma unroll
                  for (int j = 0; j < 8; ++j) { const float v = bf2f((unsigned short)qf[ks][j]); qn += v * v; }
              qn += __shfl_xor(qn, 32);
#pragma unroll
              for (int o_ = 1; o_ < 32; o_ <<= 1) qn = fmaxf(qn, __shfl_xor(qn, o_));
              ubq = sqrtf(qn * kmax2) * C1 * 1.01f + 1.f; }
            f32x16 o[4];
#pragma unroll
            for (int d = 0; d < 4; ++d)
#pragma unroll
                for (int e = 0; e < 16; ++e) o[d][e] = 0.f;
            float m = -1e30f, l = 0.f;
            const bf16* kvbase = PROJ + (size_t)b * SEQ * PROJ_N + PJ_FK + h * 128;
            const float* cfb = CF + (size_t)bh * SEQ;
            const int tl = C.wave >> 2, pc0 = (C.wave & 3) * 4;
            unsigned koff[4], voff[4];
#pragma unroll
            for (int i = 0; i < 4; ++i) { const int pc = pc0 + i, row = 4 * pc + (lane >> 4), sch = (lane & 15) ^ (row & 15);
                koff[i] = (unsigned)(((tl * 64 + row) * PROJ_N + sch * 8) * 2);
                const int sidx = 2 * pc + (lane >> 5), key = 8 * (sidx >> 2) + ((lane & 31) >> 2), col = 32 * (sidx & 3) + 8 * (lane & 3);
                voff[i] = (unsigned)(((tl * 64 + key) * PROJ_N + (PJ_FV - PJ_FK) + col) * 2); }
#define FOX_STAGE(stp, bufi) do { const char* gb_ = (const char*)(kvbase + (size_t)(128 * (stp)) * PROJ_N); const unsigned lb_ = ldsb + (bufi) * FB + tl * 16384 + pc0 * 1024; \
                _Pragma("unroll") for (int i_ = 0; i_ < 4; ++i_) { glds16s(gb_, koff[i_], lb_ + i_ * 1024); glds16s(gb_, voff[i_], lb_ + 32768 + i_ * 1024); } \
                if (C.wave < 2) glds4s(cfb + 128 * (stp) + C.wave * 64, (unsigned)(lane * 4), ldsb + (bufi) * FB + 65536 + C.wave * 256); } while (0)
            __syncthreads();
            if (C.tid < 16) STOPF[C.tid] = 0;
            FOX_STAGE(X, 0);
            int st = X, bufi = 0;
#pragma unroll 1
            for (;;) {
                asm volatile("s_waitcnt vmcnt(0)" ::: "memory");
                __syncthreads();
                volatile LAS int* sfr = STOPF + (((st + 1) & 1) << 3);
                const bool allstop = (sfr[0] & sfr[1] & sfr[2] & sfr[3] & sfr[4] & sfr[5] & sfr[6] & sfr[7]) != 0;
                const bool stage_next = (st > 0) && !allstop;
                if (stage_next) FOX_STAGE(st - 1, bufi ^ 1);
                LAS unsigned char* Ks = C.lds + bufi * FB; LAS unsigned char* Vs = Ks + 32768; const LAS float* NBs = (const LAS float*)(Ks + 65536);
                f32x16 s0, s1;
#pragma unroll
                for (int e = 0; e < 16; ++e) { s0[e] = 0.f; s1[e] = 0.f; }
                const LAS unsigned char* kt = Ks + kh * 16384;
                const LAS unsigned char* kr0 = kt + r * 256; const int kx = (r & 15) << 4;
                bf16x8 a0 = *(const LAS bf16x8*)(kr0 + ((hh * 16) ^ kx)), a1 = *(const LAS bf16x8*)(kr0 + 8192 + ((hh * 16) ^ kx));
#pragma unroll
                for (int ks = 0; ks < 8; ++ks) {
                    bf16x8 n0 = a0, n1 = a1;
                    if (ks < 7) { n0 = *(const LAS bf16x8*)(kr0 + (((ks + 1) * 32 + hh * 16) ^ kx)); n1 = *(const LAS bf16x8*)(kr0 + 8192 + (((ks + 1) * 32 + hh * 16) ^ kx)); }
                    s0 = MFMA32(a0, qf[ks], s0); s1 = MFMA32(a1, qf[ks], s1);
                    __builtin_amdgcn_sched_barrier(0);
                    a0 = n0; a1 = n1;
                }
                const int keyb = 128 * st + 64 * kh;
                const LAS float* nb = NBs + 64 * kh + 4 * hh;
#pragma unroll
                for (int g = 0; g < 4; ++g) { const f32x4 b0 = *(const LAS f32x4*)(nb + 8 * g), b1 = *(const LAS f32x4*)(nb + 32 + 8 * g);
#pragma unroll
                    for (int j = 0; j < 4; ++j) { s0[4 * g + j] = s0[4 * g + j] * C1 + b0[j]; s1[4 * g + j] = s1[4 * g + j] * C1 + b1[j]; } }
                if (st == X) {
                    const int qabs = q0 + 32 * qi + r; const float NEG = -__builtin_inff();
#pragma unroll
                    for (int e = 0; e < 16; ++e) { const int key = keyb + (e & 3) + 8 * (e >> 2) + 4 * hh;
                        if (key > qabs) s0[e] = NEG; if (key + 32 > qabs) s1[e] = NEG; }
                }
                float mx = s0[0];
#pragma unroll
                for (int e = 1; e < 16; ++e) mx = fmaxf(mx, s0[e]);
#pragma unroll
                for (int e = 0; e < 16; ++e) mx = fmaxf(mx, s1[e]);
                mx = fmaxf(mx, __shfl_xor(mx, 32));
                const float mn = fmaxf(m, mx), alpha = __builtin_amdgcn_exp2f(m - mn); m = mn;
                float ps = 0.f;
#pragma unroll
                for (int e = 0; e < 16; ++e) { s0[e] = __builtin_amdgcn_exp2f(s0[e] - mn); s1[e] = __builtin_amdgcn_exp2f(s1[e] - mn); ps += s0[e] + s1[e]; }
                l = l * alpha + ps;
#pragma unroll
                for (int d = 0; d < 4; ++d)
#pragma unroll
                    for (int e = 0; e < 16; ++e) o[d][e] *= alpha;
                __builtin_amdgcn_sched_barrier(0);
                bf16x8 pb[2][2]; pb[0][0] = pack8(s0, 0); pb[0][1] = pack8(s0, 1); pb[1][0] = pack8(s1, 0); pb[1][1] = pack8(s1, 1);
                const LAS unsigned char* vt = Vs + kh * 16384 + vlane;
#define FOX_VLD(dst, grp) do { _Pragma("unroll") for (int d_ = 0; d_ < 4; ++d_) { \
                    const s16x4 lo_ = tr_read(vt + ((2 * (grp)) * 4 + d_) * 512), hi_ = tr_read(vt + ((2 * (grp) + 1) * 4 + d_) * 512); \
                    dst[d_] = __builtin_shufflevector(lo_, hi_, 0, 1, 2, 3, 4, 5, 6, 7); } } while (0)
                bf16x8 va[4], vn[4];
                FOX_VLD(va, 0);
#pragma unroll
                for (int grp = 0; grp < 4; ++grp) {
                    if (grp < 3) FOX_VLD(vn, grp + 1);
#pragma unroll
                    for (int d = 0; d < 4; ++d) o[d] = MFMA32(va[d], pb[grp >> 1][grp & 1], o[d]);
                    __builtin_amdgcn_sched_barrier(0);
                    if (grp < 3) {
#pragma unroll
                        for (int d = 0; d < 4; ++d) va[d] = vn[d]; }
                }
                { int stopw = 0;
                  if (st >= 2) { float mmin = m;
#pragma unroll
                      for (int o_ = 1; o_ < 32; o_ <<= 1) mmin = fminf(mmin, __shfl_xor(mmin, o_));
                      stopw = (cfb[128 * (st - 2) + 127] + ubq < mmin - 40.f) ? 1 : 0; }
                  if (lane == 0) STOPF[((st & 1) << 3) + C.wave] = stopw; }
                if (!stage_next) break;
                st -= 1; bufi ^= 1;
            }
            l += __shfl_xor(l, 32);
            __syncthreads();
            if (kh == 1) {
#pragma unroll
                for (int d = 0; d < 4; ++d)
#pragma unroll
                    for (int e = 0; e < 16; ++e) XCH[(d * 16 + e) * 256 + qi * 64 + lane] = o[d][e];
                XCH[64 * 256 + qi * 64 + lane] = m; XCH[65 * 256 + qi * 64 + lane] = l;
            }
            __syncthreads();
            if (kh == 0) {
                const float m1 = XCH[64 * 256 + qi * 64 + lane], l1 = XCH[65 * 256 + qi * 64 + lane];
                const float mm = fmaxf(m, m1), a0 = __builtin_amdgcn_exp2f(m - mm), a1 = __builtin_amdgcn_exp2f(m1 - mm);
                const float inv = 1.f / (l * a0 + l1 * a1), w0 = a0 * inv, w1 = a1 * inv;
                LAS unsigned char* ot = C.lds + 67584 + qi * 8704;
#pragma unroll
                for (int d = 0; d < 4; ++d)
#pragma unroll
                    for (int g = 0; g < 4; ++g) { float y[4];
#pragma unroll
                        for (int j = 0; j < 4; ++j) y[j] = o[d][4 * g + j] * w0 + XCH[(d * 16 + 4 * g + j) * 256 + qi * 64 + lane] * w1;
                        v2u w; w.x = cvtpk(y[0], y[1]); w.y = cvtpk(y[2], y[3]);
                        *(LAS v2u*)(ot + r * 272 + (32 * d + 8 * g + 4 * hh) * 2) = w; }
                LDS_WAIT(); asm volatile("" ::: "memory");
                char* obase = (char*)(CAT + qrow0 * LDP + 1024 + h * 128);
#pragma unroll
                for (int i = 0; i < 8; ++i) { const int row = 4 * i + (lane >> 4), ch = lane & 15;
                    *(v4u*)(obase + (unsigned)(row * LDP * 2 + ch * 16)) = *(const LAS v4u*)(ot + row * 272 + ch * 16); }
            }
        }
    }
}
__device__ __forceinline__ void xattn_phase(const Ctx& C) {
    const bf16* Q2 = (const bf16*)(C.ws + WS_Q2); const bf16* KV2 = (const bf16*)(C.ws + WS_KV2); unsigned char* XO = (unsigned char*)(C.ws + WS_XO);
    const int lane = C.lane, r = lane & 31, hh = lane >> 5, qi = C.wave & 3, kh = C.wave >> 2;
    const int i16 = lane & 15, blk = (lane >> 4) & 1;
    const unsigned ldsb = (unsigned)(unsigned long long)C.lds;
    const int vlane = (4 * hh + (i16 >> 2)) * 64 + 32 * blk + 8 * (i16 & 3);
    LAS float* EXM = (LAS float*)(C.lds + 65536); LAS float* EXL = EXM + 512; LAS unsigned char* PX = C.lds + 65536 + 4096;
    for (int unit = C.bid; unit < 256; unit += C.G) {
        const int b = unit >> 7, hd = (unit >> 5) & 3, qb = unit & 31;
        const size_t qrow0 = (size_t)b * SEQ + qb * 128 + 32 * qi;
        const char* qbase = (const char*)(Q2 + qrow0 * D + hd * XDH); const unsigned qlo = (unsigned)((r * D + 8 * hh) * 2);
        const char* kvb = (const char*)(KV2 + (size_t)b * MEM_LEN * 2 * D + hd * XDH);
        unsigned koff[8], voff[8];
#pragma unroll
        for (int i = 0; i < 8; ++i) { const int pc = C.wave * 8 + i;
            { const int half = pc >> 5, row = 4 * (pc & 31) + (lane >> 4), sch = (lane & 15) ^ (row & 15); koff[i] = (unsigned)(((128 * half + row) * 2 * D + sch * 8) * 2); }
            { const int sidx = 2 * pc + (lane >> 5), key = 8 * (sidx >> 2) + ((lane & 31) >> 2), col = 32 * (sidx & 3) + 8 * (lane & 3); voff[i] = (unsigned)((key * 2 * D + D + col) * 2); } }
#define XA_STAGE_K(c, bufi) do { _Pragma("unroll") for (int i_ = 0; i_ < 8; ++i_) glds16s(kvb + (c) * 256, koff[i_], ldsb + (bufi) * 65536 + (C.wave * 8 + i_) * 1024); } while (0)
#define XA_STAGE_V(c, bufi) do { _Pragma("unroll") for (int i_ = 0; i_ < 8; ++i_) glds16s(kvb + (c) * 256, voff[i_], ldsb + (bufi) * 65536 + (C.wave * 8 + i_) * 1024); } while (0)
        f32x16 sT[4];
#pragma unroll
        for (int kb = 0; kb < 4; ++kb)
#pragma unroll
            for (int e = 0; e < 16; ++e) sT[kb][e] = 0.f;
        bf16x8 qf[8], qn[8];
#pragma unroll
        for (int ks = 0; ks < 8; ++ks) qf[ks] = *(const bf16x8*)(qbase + qlo + 32 * ks);
        __syncthreads();
        XA_STAGE_K(0, 0);
#pragma unroll 1
        for (int c = 0; c < 4; ++c) {
            asm volatile("s_waitcnt vmcnt(0)" ::: "memory");
            __syncthreads();
            if (c < 3) {
#pragma unroll
                for (int ks = 0; ks < 8; ++ks) qn[ks] = *(const bf16x8*)(qbase + qlo + (c + 1) * 256 + 32 * ks);
                XA_STAGE_K(c + 1, (c + 1) & 1);
            } else { XA_STAGE_V(0, 0); }
            const LAS unsigned char* kr0 = C.lds + (c & 1) * 65536 + kh * 32768 + r * 256; const int kx = (r & 15) << 4;
            bf16x8 a[4], an[4];
#pragma unroll
            for (int kb = 0; kb < 4; ++kb) a[kb] = *(const LAS bf16x8*)(kr0 + kb * 8192 + ((hh * 16) ^ kx));
#pragma unroll
            for (int ks = 0; ks < 8; ++ks) {
                if (ks < 7) {
#pragma unroll
                    for (int kb = 0; kb < 4; ++kb) an[kb] = *(const LAS bf16x8*)(kr0 + kb * 8192 + (((ks + 1) * 32 + hh * 16) ^ kx)); }
#pragma unroll
                for (int kb = 0; kb < 4; ++kb) sT[kb] = MFMA32(a[kb], qf[ks], sT[kb]);
                __builtin_amdgcn_sched_barrier(0);
                if (ks < 7) {
#pragma unroll
                    for (int kb = 0; kb < 4; ++kb) a[kb] = an[kb]; }
            }
            if (c < 3) {
#pragma unroll
                for (int ks = 0; ks < 8; ++ks) qf[ks] = qn[ks]; }
        }
        float mloc = sT[0][0];
#pragma unroll
        for (int kb = 0; kb < 4; ++kb)
#pragma unroll
            for (int e = 0; e < 16; ++e) mloc = fmaxf(mloc, sT[kb][e]);
        mloc = fmaxf(mloc, __shfl_xor(mloc, 32));
        __syncthreads();
        EXM[C.wave * 64 + lane] = mloc;
        __syncthreads();
        const float mm = fmaxf(mloc, EXM[(C.wave ^ 4) * 64 + lane]);
        float lloc = 0.f;
#pragma unroll
        for (int kb = 0; kb < 4; ++kb)
#pragma unroll
            for (int e = 0; e < 16; ++e) { sT[kb][e] = __builtin_amdgcn_exp2f(sT[kb][e] - mm); lloc += sT[kb][e]; }
        lloc += __shfl_xor(lloc, 32);
        bf16x8 pb[8];
#pragma unroll
        for (int f = 0; f < 8; ++f) pb[f] = pack8(sT[f >> 1], f & 1);
#pragma unroll
        for (int f = 0; f < 8; ++f) *(LAS bf16x8*)(PX + ((C.wave * 8 + f) * 64 + lane) * 16) = pb[f];
        EXL[C.wave * 64 + lane] = lloc;
        __syncthreads();
        bf16x8 pq[8];
#pragma unroll
        for (int f = 0; f < 8; ++f) pq[f] = *(const LAS bf16x8*)(PX + (((C.wave ^ 4) * 8 + f) * 64 + lane) * 16);
        const float inv = 1.f / (lloc + EXL[(C.wave ^ 4) * 64 + lane]);
        bf16x8 pall[16];
#pragma unroll
        for (int f = 0; f < 8; ++f) { pall[f] = kh ? pq[f] : pb[f]; pall[8 + f] = kh ? pb[f] : pq[f]; }
        char* obase = (char*)(XO + qrow0 * D + hd * XDH); const unsigned olo = (unsigned)(r * D + 4 * hh); const float osc = inv * O8_SCALE;
#pragma unroll 1
        for (int cc = 0; cc < 4; ++cc) {
            asm volatile("s_waitcnt vmcnt(0)" ::: "memory");
            __syncthreads();
            if (cc < 3) XA_STAGE_V(cc + 1, (cc + 1) & 1);
            const LAS unsigned char* vt = C.lds + (cc & 1) * 65536 + vlane + (2 * kh) * 512;
            f32x16 o[2];
#pragma unroll
            for (int j = 0; j < 2; ++j)
#pragma unroll
                for (int e = 0; e < 16; ++e) o[j][e] = 0.f;
#define XA_VLD(dst, kg) do { _Pragma("unroll") for (int j_ = 0; j_ < 2; ++j_) { \
                const s16x4 lo_ = tr_read(vt + ((2 * (kg)) * 4 + j_) * 512), hi_ = tr_read(vt + ((2 * (kg) + 1) * 4 + j_) * 512); \
                dst[j_] = __builtin_shufflevector(lo_, hi_, 0, 1, 2, 3, 4, 5, 6, 7); } } while (0)
            bf16x8 va[2], vn[2];
            XA_VLD(va, 0);
#pragma unroll
            for (int kg = 0; kg < 16; ++kg) {
                if (kg < 15) XA_VLD(vn, kg + 1);
                o[0] = MFMA32(va[0], pall[kg], o[0]); o[1] = MFMA32(va[1], pall[kg], o[1]);
                __builtin_amdgcn_sched_barrier(0);
                if (kg < 15) { va[0] = vn[0]; va[1] = vn[1]; }
            }
#pragma unroll
            for (int j = 0; j < 2; ++j)
#pragma unroll
                for (int g = 0; g < 4; ++g) { int w = 0; w = __builtin_amdgcn_cvt_pk_fp8_f32(o[j][4 * g] * osc, o[j][4 * g + 1] * osc, w, false); w = __builtin_amdgcn_cvt_pk_fp8_f32(o[j][4 * g + 2] * osc, o[j][4 * g + 3] * osc, w, true);
                    *(int*)(obase + olo + (128 * cc + 32 * (2 * kh + j) + 8 * g)) = w; }
        }
    }
}
constexpr size_t WS_KVT = WS_HH;
constexpr size_t WS_SB  = WS_HH + (size_t)512 * 256 * 128 * 2;
constexpr size_t WS_DEC = WS_SB + (size_t)512 * 256 * 128 * 2;
constexpr size_t WS_QIN = WS_DEC + (size_t)512 * 128 * 4;
constexpr size_t WS_KIN = WS_QIN + (size_t)T * 512 * 2;
static_assert(WS_KIN + (size_t)T * 512 * 2 <= WS_YY, "GLA scratch inside HH");
constexpr int GL_V = 0, GL_QI = 32768, GL_KI = GL_QI + 16384, GL_PM = GL_KI + 16384, GL_GA = GL_PM + 64 * 144, GL_SEG = GL_GA + 4096, GL_KET = GL_QI, GL_OT = 0;

__device__ __forceinline__ void gla_G(const Ctx& C, const Args& A, int h, size_t tok0, float (&g)[16], float& glast) {
    LAS float* GAs = (LAS float*)(C.lds + GL_GA); LAS float* SEG = (LAS float*)(C.lds + GL_SEG);
    const float* GA = (const float*)(C.ws + WS_GA);
    const int dk = C.tid & 127, tq = C.tid >> 7;
    { const float2 v = *(const float2*)(GA + tok0 * 16 + 2 * C.tid); GAs[2 * C.tid] = v.x; GAs[2 * C.tid + 1] = v.y; }
    float w[16];
#pragma unroll
    for (int j = 0; j < 16; ++j) w[j] = A.in[I_W_ALPHA][j * 512 + h * 128 + dk];
    const float bias = A.in[I_B_ALPHA][h * 128 + dk];
    __syncthreads();
    float run = 0.f;
#pragma unroll
    for (int i = 0; i < 16; ++i) { const LAS float* ga = GAs + (16 * tq + i) * 16; float z = bias;
#pragma unroll
        for (int j = 0; j < 16; ++j) z += ga[j] * w[j];
        run += (fminf(z, 0.f) - __logf(1.f + __expf(-fabsf(z)))) * (1.f / 16.f); g[i] = run; }
    SEG[tq * 128 + dk] = run;
    __syncthreads();
    float pre = 0.f, tot = 0.f;
#pragma unroll
    for (int q = 0; q < 4; ++q) { const float s = SEG[q * 128 + dk]; tot += s; pre += (q < tq) ? s : 0.f; }
#pragma unroll
    for (int i = 0; i < 16; ++i) g[i] += pre;
    glast = tot;
}
__device__ __forceinline__ void gla_stage_v(const Ctx& C, const bf16* vsrc  ) {
    const unsigned ldsb = (unsigned)(unsigned long long)C.lds;
#pragma unroll
    for (int i = 0; i < 4; ++i) { const int pc = C.wave * 4 + i, sidx = 2 * pc + (C.lane >> 5), t = 8 * (sidx >> 3) + ((C.lane & 31) >> 2), col = 32 * (sidx & 7) + 8 * (C.lane & 3);
        glds16s(vsrc, (unsigned)((t * PROJ_N + col) * 2), ldsb + GL_V + pc * 1024); }
}
__device__ __forceinline__ void gla_a_phase(const Ctx& C, const Args& A) {
    const bf16* PROJ = (const bf16*)(C.ws + WS_PROJ); bf16* KVT = (bf16*)(C.ws + WS_KVT); float* DEC = (float*)(C.ws + WS_DEC);
    const int lane = C.lane, r = lane & 31, hh = lane >> 5, i16 = lane & 15, blk = (lane >> 4) & 1;
    const int dk = C.tid & 127, tq = C.tid >> 7;
    LAS unsigned char* KET = C.lds + GL_KET;
    for (int unit = C.bid; unit < 512; unit += C.G) {
        const int bh = unit >> 6, n = unit & 63, b = bh >> 2, h = bh & 3; const size_t tok0 = (size_t)b * SEQ + 64 * n;
        __syncthreads();
        gla_stage_v(C, PROJ + tok0 * PROJ_N + PJ_GV + h * 256);
        float qv[16], kv[16];
#pragma unroll
        for (int i = 0; i < 16; ++i) { const size_t t0 = tok0 + 16 * tq + i; kv[i] = bf2f(PROJ[t0 * PROJ_N + PJ_GK + h * 128 + dk]); qv[i] = bf2f(PROJ[t0 * PROJ_N + PJ_GQ + h * 128 + dk]); }
        float g[16], glast; gla_G(C, A, h, tok0, g, glast);
        { unsigned pk[8]; bf16* QIN = (bf16*)(C.ws + WS_QIN); bf16* KIN = (bf16*)(C.ws + WS_KIN);
#pragma unroll
          for (int i = 0; i < 16; i += 2) { const size_t t0 = tok0 + 16 * tq + i;
              pk[i >> 1] = cvtpk(kv[i] * __expf(glast - g[i]), kv[i + 1] * __expf(glast - g[i + 1]));
              const float e0 = __expf(g[i]), e1 = __expf(g[i + 1]);
              QIN[t0 * 512 + h * 128 + dk] = (bf16)f2bf(qv[i] * e0); QIN[(t0 + 1) * 512 + h * 128 + dk] = (bf16)f2bf(qv[i + 1] * e1);
              KIN[t0 * 512 + h * 128 + dk] = (bf16)f2bf(kv[i] * __builtin_amdgcn_rcpf(e0)); KIN[(t0 + 1) * 512 + h * 128 + dk] = (bf16)f2bf(kv[i + 1] * __builtin_amdgcn_rcpf(e1)); }
          *(LAS v4u*)(KET + dk * 144 + tq * 32) = (v4u){pk[0], pk[1], pk[2], pk[3]}; *(LAS v4u*)(KET + dk * 144 + tq * 32 + 16) = (v4u){pk[4], pk[5], pk[6], pk[7]}; }
        if (tq == 0) DEC[(size_t)unit * 128 + dk] = __expf(glast);
        asm volatile("s_waitcnt vmcnt(0)" ::: "memory");
        __syncthreads();
        f32x16 acc[4];
#pragma unroll
        for (int q = 0; q < 4; ++q)
#pragma unroll
            for (int e = 0; e < 16; ++e) acc[q][e] = 0.f;
        const LAS unsigned char* vt = C.lds + GL_V + C.wave * 512 + (i16 >> 2) * 64 + 32 * blk + 8 * (i16 & 3);
#pragma unroll
        for (int ks = 0; ks < 4; ++ks) {
            const s16x4 lo = tr_read(vt + ((2 * ks + hh) * 8) * 512), hi = tr_read(vt + ((2 * ks + hh) * 8) * 512 + 256);
            const bf16x8 vb = __builtin_shufflevector(lo, hi, 0, 1, 2, 3, 4, 5, 6, 7);
#pragma unroll
            for (int q = 0; q < 4; ++q) { const bf16x8 ka = *(const LAS bf16x8*)(KET + (32 * q + r) * 144 + (16 * ks + 8 * hh) * 2); acc[q] = MFMA32(ka, vb, acc[q]); }
        }
        char* ob = (char*)(KVT + ((size_t)unit * 256 + 32 * C.wave) * 128); const unsigned olo = (unsigned)((r * 128 + 4 * hh) * 2);
#pragma unroll
        for (int q = 0; q < 4; ++q)
#pragma unroll
            for (int gq = 0; gq < 4; ++gq) { v2u w; w.x = cvtpk(acc[q][4 * gq], acc[q][4 * gq + 1]); w.y = cvtpk(acc[q][4 * gq + 2], acc[q][4 * gq + 3]);
                *(v2u*)(ob + olo + (32 * q + 8 * gq) * 2) = w; }
    }
}
__device__ __forceinline__ void gla_scan_phase(const Ctx& C) {
    const unsigned* KVT = (const unsigned*)(C.ws + WS_KVT); unsigned* SB = (unsigned*)(C.ws + WS_SB); const float* DEC = (const float*)(C.ws + WS_DEC);
    for (int it = C.bid * 512 + C.tid; it < 8 * 16384; it += C.G * 512) {
        const int bh = it >> 14, e2 = it & 16383, dk2 = (e2 & 63) * 2;
        float s0 = 0.f, s1 = 0.f;
#pragma unroll 1
        for (int n0 = 0; n0 < 64; n0 += 16) {
            unsigned kv[16]; float2 d[16];
#pragma unroll
            for (int j = 0; j < 16; ++j) { const size_t u = (size_t)bh * 64 + n0 + j; kv[j] = KVT[u * 16384 + e2]; d[j] = *(const float2*)(DEC + u * 128 + dk2); }
#pragma unroll
            for (int j = 0; j < 16; ++j) { const size_t u = (size_t)bh * 64 + n0 + j;
                SB[u * 16384 + e2] = cvtpk(s0, s1);
                s0 = d[j].x * s0 + bflo(kv[j]); s1 = d[j].y * s1 + bfhi(kv[j]); } }
    }
}
__device__ __forceinline__ void gla_c_phase(const Ctx& C, const Args& A, int first, int stride) {
    const bf16* PROJ = (const bf16*)(C.ws + WS_PROJ); const bf16* SB = (const bf16*)(C.ws + WS_SB); bf16* CAT = (bf16*)(C.ws + WS_CAT);
    const bf16* QIN = (const bf16*)(C.ws + WS_QIN); const bf16* KIN = (const bf16*)(C.ws + WS_KIN);
    const int lane = C.lane, r = lane & 31, hh = lane >> 5, i16 = lane & 15, blk = (lane >> 4) & 1;
    const unsigned ldsb = (unsigned)(unsigned long long)C.lds;
    LAS unsigned char* QI = C.lds + GL_QI; LAS unsigned char* KI = C.lds + GL_KI; LAS unsigned char* PM = C.lds + GL_PM; LAS float* OT = (LAS float*)(C.lds + GL_OT);
    const int kx = (r & 15) << 4;
    for (int unit = first; unit < 512; unit += stride) {
        const int bh = unit >> 6, n = unit & 63, b = bh >> 2, h = bh & 3; const size_t tok0 = (size_t)b * SEQ + 64 * n;
        __syncthreads();
        gla_stage_v(C, PROJ + tok0 * PROJ_N + PJ_GV + h * 256);
#pragma unroll
        for (int i = 0; i < 2; ++i) { const int pc = C.wave * 2 + i, row = 4 * pc + (lane >> 4), sch = (lane & 15) ^ (row & 15); const unsigned off = (unsigned)((row * 512 + sch * 8) * 2);
            glds16s(QIN + tok0 * 512 + h * 128, off, ldsb + GL_QI + pc * 1024); glds16s(KIN + tok0 * 512 + h * 128, off, ldsb + GL_KI + pc * 1024); }
        bf16x8 sf[8];
        { const char* sb = (const char*)(SB + ((size_t)unit * 256 + 32 * C.wave) * 128); const unsigned slo = (unsigned)((r * 128 + 8 * hh) * 2);
#pragma unroll
          for (int ks = 0; ks < 8; ++ks) sf[ks] = *(const bf16x8*)(sb + slo + 32 * ks); }
        asm volatile("s_waitcnt vmcnt(0)" ::: "memory");
        __syncthreads();
        if (C.wave < 4 && C.wave != 1) { const int tb = C.wave >> 1, sb = C.wave & 1;
            f32x16 am;
#pragma unroll
            for (int e = 0; e < 16; ++e) am[e] = 0.f;
#pragma unroll
            for (int ks = 0; ks < 8; ++ks) { const bf16x8 qa = *(const LAS bf16x8*)(QI + (32 * tb + r) * 256 + ((ks * 32 + hh * 16) ^ kx)), kb = *(const LAS bf16x8*)(KI + (32 * sb + r) * 256 + ((ks * 32 + hh * 16) ^ kx));
                am = MFMA32(qa, kb, am); }
#pragma unroll
            for (int e = 0; e < 16; ++e) { const int t = 32 * tb + (e & 3) + 8 * (e >> 2) + 4 * hh, s = 32 * sb + r;
                *(LAS unsigned short*)(PM + t * 144 + s * 2) = (unsigned short)f2bf(s <= t ? am[e] : 0.f); } }
        __syncthreads();
        f32x16 o[2];
#pragma unroll
        for (int tb = 0; tb < 2; ++tb)
#pragma unroll
            for (int e = 0; e < 16; ++e) o[tb][e] = 0.f;
#pragma unroll
        for (int ks = 0; ks < 8; ++ks)
#pragma unroll
            for (int tb = 0; tb < 2; ++tb) { const bf16x8 qa = *(const LAS bf16x8*)(QI + (32 * tb + r) * 256 + ((ks * 32 + hh * 16) ^ kx)); o[tb] = MFMA32(qa, sf[ks], o[tb]); }
        const LAS unsigned char* vt = C.lds + GL_V + C.wave * 512 + (i16 >> 2) * 64 + 32 * blk + 8 * (i16 & 3);
#pragma unroll
        for (int ks = 0; ks < 4; ++ks) {
            const s16x4 lo = tr_read(vt + ((2 * ks + hh) * 8) * 512), hi = tr_read(vt + ((2 * ks + hh) * 8) * 512 + 256);
            const bf16x8 vb = __builtin_shufflevector(lo, hi, 0, 1, 2, 3, 4, 5, 6, 7);
            if (ks < 2) { const bf16x8 pa = *(const LAS bf16x8*)(PM + r * 144 + (16 * ks + 8 * hh) * 2); o[0] = MFMA32(pa, vb, o[0]); }
            { const bf16x8 pa = *(const LAS bf16x8*)(PM + (32 + r) * 144 + (16 * ks + 8 * hh) * 2); o[1] = MFMA32(pa, vb, o[1]); }
        }
        __syncthreads();
#pragma unroll
        for (int tb = 0; tb < 2; ++tb)
#pragma unroll
            for (int e = 0; e < 16; ++e) OT[(32 * tb + (e & 3) + 8 * (e >> 2) + 4 * hh) * 260 + 32 * C.wave + r] = o[tb][e];
        __syncthreads();
        { const int t = C.tid >> 3, part = C.tid & 7; const size_t tok = tok0 + t;
          f32x4 v[8]; float ss = 0.f;
#pragma unroll
          for (int j = 0; j < 8; ++j) { v[j] = *(const LAS f32x4*)(OT + t * 260 + 32 * part + 4 * j); ss += (v[j].x * v[j].x + v[j].y * v[j].y) + (v[j].z * v[j].z + v[j].w * v[j].w); }
          ss += __shfl_xor(ss, 1); ss += __shfl_xor(ss, 2); ss += __shfl_xor(ss, 4);
          const float rstd = rsqrtf(ss * (1.f / 256.f) + EPS);
          const v4u* grp = (const v4u*)(PROJ + tok * PROJ_N + PJ_GR + h * 256 + 32 * part); const f32x4* gnp = (const f32x4*)(A.in[I_GLA_NORM] + 32 * part);
          v4u* op = (v4u*)(CAT + tok * LDP + h * 256 + 32 * part);
          v4u gwv[4]; f32x4 gnv[8];
#pragma unroll
          for (int q = 0; q < 4; ++q) { gwv[q] = grp[q]; gnv[2 * q] = gnp[2 * q]; gnv[2 * q + 1] = gnp[2 * q + 1]; }
#pragma unroll
          for (int q = 0; q < 4; ++q) { const v4u gw = gwv[q]; const f32x4 a = v[2 * q] * rstd * gnv[2 * q], c = v[2 * q + 1] * rstd * gnv[2 * q + 1];
              v4u w; w.x = cvtpk(a.x * silu(bflo(gw.x)), a.y * silu(bfhi(gw.x))); w.y = cvtpk(a.z * silu(bflo(gw.y)), a.w * silu(bfhi(gw.y)));
              w.z = cvtpk(c.x * silu(bflo(gw.z)), c.y * silu(bfhi(gw.z))); w.w = cvtpk(c.z * silu(bflo(gw.w)), c.w * silu(bfhi(gw.w)));
              op[q] = w; } }
    }
}

__device__ __forceinline__ void fox_knorm_phase(const Ctx& C) {
    const bf16* PROJ = (const bf16*)(C.ws + WS_PROJ); unsigned* KM = (unsigned*)(C.ws + WS_CTL) + CW_KMAX;
    for (int blk = C.gw; blk < 16 * SEQ / 32; blk += C.ngw) {
        const int bh = blk >> 7, b = bh >> 3, h = bh & 7; float mx = 0.f;
#pragma unroll
        for (int i = 0; i < 8; ++i) { const int s = (blk & 127) * 32 + 4 * i + (C.lane >> 4);
            const v4u w = *(const v4u*)(PROJ + ((size_t)b * SEQ + s) * PROJ_N + PJ_FK + h * 128 + 8 * (C.lane & 15));
            float q = bflo(w.x) * bflo(w.x) + bfhi(w.x) * bfhi(w.x) + bflo(w.y) * bflo(w.y) + bfhi(w.y) * bfhi(w.y) + bflo(w.z) * bflo(w.z) + bfhi(w.z) * bfhi(w.z) + bflo(w.w) * bflo(w.w) + bfhi(w.w) * bfhi(w.w);
            q += __shfl_xor(q, 1); q += __shfl_xor(q, 2); q += __shfl_xor(q, 4); q += __shfl_xor(q, 8);
            mx = fmaxf(mx, q); }
        mx = fmaxf(mx, __shfl_xor(mx, 16)); mx = fmaxf(mx, __shfl_xor(mx, 32));
        if (C.lane == 0) atomicMax(KM + bh, __float_as_uint(mx));
    }
}
__device__ __forceinline__ void router_phase(const Ctx& C, const Args& A) {
    const float* H2 = (const float*)(C.ws + WS_H2); bf16* XN = (bf16*)(C.ws + WS_XN);
    int* TOPE = (int*)(C.ws + WS_TOPE); float* TOPG = (float*)(C.ws + WS_TOPG); int* CNT = (int*)(C.ws + WS_CNT);
    const float* wr = A.in[I_W_ROUTER]; const float* br = A.in[I_B_ROUTER]; const float* nm = A.in[I_NORM_MOE];
    LAS int* cnt = (LAS int*)(C.lds); LAS float* RS = (LAS float*)(C.lds + 256); LAS float* PART = (LAS float*)(C.lds + 1024); LAS float* LG = (LAS float*)(C.lds + 1024 + 32768);
    const int lane = C.lane, tl = lane & 31, kk = lane >> 5;
    for (int blk = C.bid; blk < 256; blk += C.G) {
        __syncthreads();
        if (C.tid < 32) cnt[C.tid] = 0;
        rows32_proj<1>(C, blk, H2, nm, wr, NE, lane & 31, XN);
        if (C.tid < 32) { const int t = blk * 32 + C.tid;
            float lg[32];
#pragma unroll
            for (int e = 0; e < 32; ++e) lg[e] = LG[C.tid * 33 + e] + br[e];
            unsigned taken = 0u; int te[4]; float tv[4];
#pragma unroll
            for (int k4 = 0; k4 < 4; ++k4) { float best = -3.0e38f; int bi = 0;
#pragma unroll
                for (int e = 0; e < 32; ++e) { const bool ok = !((taken >> e) & 1u) && (lg[e] > best); best = ok ? lg[e] : best; bi = ok ? e : bi; }
                taken |= 1u << bi; te[k4] = bi; tv[k4] = best; }
            const float p1 = __expf(tv[1] - tv[0]), p2 = __expf(tv[2] - tv[0]), p3 = __expf(tv[3] - tv[0]); const float inv = 1.f / (1.f + p1 + p2 + p3);
            TOPE[t * 4 + 0] = te[0]; TOPE[t * 4 + 1] = te[1]; TOPE[t * 4 + 2] = te[2]; TOPE[t * 4 + 3] = te[3];
            TOPG[t * 4 + 0] = inv; TOPG[t * 4 + 1] = p1 * inv; TOPG[t * 4 + 2] = p2 * inv; TOPG[t * 4 + 3] = p3 * inv;
            atomicAdd((int*)&cnt[te[0]], 1); atomicAdd((int*)&cnt[te[1]], 1); atomicAdd((int*)&cnt[te[2]], 1); atomicAdd((int*)&cnt[te[3]], 1);
        }
        __syncthreads();
        if (C.tid < 32) CNT[blk * 32 + C.tid] = cnt[C.tid];
        __syncthreads();
    }
}
__device__ __forceinline__ void place_phase(const Ctx& C) {
    const int* CNT = (const int*)(C.ws + WS_CNT); const int* TOPE = (const int*)(C.ws + WS_TOPE);
    int* TSLOT = (int*)(C.ws + WS_TSLOT); int* RT = (int*)(C.ws + WS_RT);
    const unsigned char* XN = (const unsigned char*)(C.ws + WS_XN); unsigned char* XS = (unsigned char*)(C.ws + WS_XS);
    LAS int* tot = (LAS int*)(C.lds); LAS int* pre = tot + 32; LAS int* ps = pre + 32; LAS int* slot_of = ps + 32; LAS int* te = slot_of + 128; LAS int* sseg = te + 128; LAS int* pseg = sseg + 512;
    for (int blk = C.bid; blk < 256; blk += C.G) {
        { const int e = C.tid & 31, seg = C.tid >> 5; int s = 0, p = 0;
#pragma unroll 16
          for (int w = seg * 16; w < seg * 16 + 16; ++w) { const int c = CNT[w * 32 + e]; s += c; p += (w < blk) ? c : 0; }
          sseg[seg * 32 + e] = s; pseg[seg * 32 + e] = p; }
        if (C.tid < 128) te[C.tid] = TOPE[blk * 128 + C.tid];
        __syncthreads();
        if (C.tid < 32) { int tt = 0, pp = 0;
#pragma unroll
            for (int q = 0; q < 16; ++q) { tt += sseg[q * 32 + C.tid]; pp += pseg[q * 32 + C.tid]; }
            tot[C.tid] = tt; pre[C.tid] = pp; }
        __syncthreads();
        if (C.tid == 0) { int run = 0; for (int e = 0; e < 32; ++e) { ps[e] = run; run += (tot[e] + 127) & ~127; } }
        __syncthreads();
        if (C.tid < 32) { int base = ps[C.tid] + pre[C.tid];
            for (int a = 0; a < 128; ++a) if (te[a] == C.tid) { slot_of[a] = base; TSLOT[blk * 128 + a] = base; ++base; } }
        __syncthreads();
        { v4u rowv[4][2];
#pragma unroll
          for (int q = 0; q < 4; ++q) { const v4u* src = (const v4u*)(XN + (size_t)(blk * 32 + C.wave * 4 + q) * D) + C.lane; rowv[q][0] = src[0]; rowv[q][1] = src[64]; }
#pragma unroll
          for (int q = 0; q < 4; ++q)
#pragma unroll
              for (int k = 0; k < 4; ++k) { const int sl = slot_of[C.wave * 16 + q * 4 + k]; v4u* dst = (v4u*)(XS + (size_t)sl * D) + C.lane; dst[0] = rowv[q][0]; dst[64] = rowv[q][1]; } }
        if (blk == 0) {
            LAS int* rtl = sseg; LAS int* eul = sseg + 600;
            __syncthreads();
            if (C.tid < 64) {
                const int e = C.tid & 31, n = tot[e], nt = (n + 255) >> 8; int inc = nt;
#pragma unroll
                for (int o_ = 1; o_ < 32; o_ <<= 1) { const int t_ = __shfl_up(inc, o_); if ((C.tid & 31) >= o_) inc += t_; }
                const int first = inc - nt;
                if (C.tid < 32) { eul[e] = first; if (e == 31) { eul[32] = inc; RT[0] = inc; }
                    for (int q = 0; q < nt; ++q) { rtl[3 * (first + q)] = (ps[e] >> 7) + 2 * q; const int rem = n - 256 * q; rtl[3 * (first + q) + 1] = rem < 256 ? rem : 256; rtl[3 * (first + q) + 2] = e; } } }
            __syncthreads();
            const int nrt = eul[32]; int* UL = (int*)(C.ws + WS_UL);
#pragma unroll 1
            for (int pass = 0; pass < 2; ++pass) { const int NT = pass ? 8 : 16; int* ul = UL + (pass ? 8192 : 0);
                for (int u = C.tid; u < nrt * NT; u += 512) { int e = 0;
                    for (int q = 1; q < 32; ++q) e += (u >= eul[q] * NT) ? 1 : 0;
                    const int n = eul[e + 1] - eul[e], lu = u - eul[e] * NT, pn = lu / n, ti = eul[e] + lu % n;
                    ul[3 * u] = rtl[3 * ti]; ul[3 * u + 1] = rtl[3 * ti + 1]; ul[3 * u + 2] = e * NT + pn; } }
        }
        __syncthreads();
    }
}
__device__ __forceinline__ void final_phase(const Ctx& C, const Args& A) {
    const float* H2 = (const float*)(C.ws + WS_H2); const unsigned char* YY = (const unsigned char*)(C.ws + WS_YY);
    const int* TSLOT = (const int*)(C.ws + WS_TSLOT); const float* TOPG = (const float*)(C.ws + WS_TOPG); const float* nf = A.in[I_NORM_FINAL];
    for (int t0 = 2 * C.gw; t0 < T; t0 += 2 * C.ngw) {
        int sl[2][4]; float gt[2][4];
#pragma unroll
        for (int p = 0; p < 2; ++p)
#pragma unroll
            for (int k = 0; k < 4; ++k) { sl[p][k] = TSLOT[(t0 + p) * 4 + k]; gt[p][k] = TOPG[(t0 + p) * 4 + k] * (1.f / Y8_SCALE); }
        f32x4 v[2][8]; unsigned yw[2][4][8];
#pragma unroll
        for (int p = 0; p < 2; ++p) { const f32x4* xr = (const f32x4*)(H2 + (size_t)(t0 + p) * D) + C.lane;
#pragma unroll
            for (int j = 0; j < 8; ++j) v[p][j] = xr[64 * j];
#pragma unroll
            for (int k = 0; k < 4; ++k) { const unsigned* yr = (const unsigned*)(YY + (size_t)sl[p][k] * D) + C.lane;
#pragma unroll
                for (int j = 0; j < 8; ++j) yw[p][k][j] = yr[64 * j]; } }
#pragma unroll
        for (int p = 0; p < 2; ++p) {
#pragma unroll
            for (int k = 0; k < 4; ++k) { const float g = gt[p][k];
#pragma unroll
                for (int j = 0; j < 8; ++j) { const unsigned w = yw[p][k][j];
                    const auto lo = __builtin_amdgcn_cvt_pk_f32_fp8((int)w, false), hi = __builtin_amdgcn_cvt_pk_f32_fp8((int)w, true);
                    v[p][j].x += g * lo[0]; v[p][j].y += g * lo[1]; v[p][j].z += g * hi[0]; v[p][j].w += g * hi[1]; } }
            float s = 0.f;
#pragma unroll
            for (int j = 0; j < 8; ++j) s += (v[p][j].x * v[p][j].x + v[p][j].y * v[p][j].y) + (v[p][j].z * v[p][j].z + v[p][j].w * v[p][j].w);
            const float rstd = rsqrtf(wave_sum(s) * (1.f / D) + EPS);
            f32x4* o = (f32x4*)(A.out + (size_t)(t0 + p) * D) + C.lane; const f32x4* gr = (const f32x4*)nf + C.lane;
#pragma unroll
            for (int j = 0; j < 8; ++j) o[64 * j] = v[p][j] * rstd * gr[64 * j]; }
    }
}

template <int K> __device__ __forceinline__ void run_phase(const Ctx& C0, const Args& args, const XcdBarrier& bar) {
    Ctx C = C0; { int t_ = lane_id(); asm volatile("" : "+v"(t_)); C.lane = t_; C.tid = C.wave * 64 + t_; }
    unsigned char* ws = args.ws; LAS unsigned char* ring = C.lds + RING_OFF; (void)ws; (void)ring; (void)bar;
    if constexpr (K == 0) { p0_prologue(C, args); }
    if constexpr (K == 1) { cumsum_cf(C);
        pg8::Gemm g{(const bf16*)(ws + WS_XN), (const bf16*)(ws + WS_WT_IN), T, PROJ_N, D}; pg8::StaticOrder S; S.init(T, PROJ_N, C.G, C.bid);
        pg8::EpiBf16S E{(bf16*)(ws + WS_PROJ), PROJ_N, 0.08838834764831845f, 2, nullptr};
#ifdef PROBE_QCONV
        { const int grp_ = (C.bid >> 3) & 3; Ctx C2 = C; C2.gw = (((C.bid >> 5) * 8 + (C.bid & 7)) * 8 + C.wave); C2.ngw = 512;
        if (grp_ == 0) { conv_items_f8(C2, args, 0, 128); conv_dense(C2, args, 3072, 8192); __syncthreads(); }
        pg8::gemm_phase<pg8::EpiBf16S, pg8::StaticOrder, true, true>(ring, g, S, E, C.wave); } }
#else
        { const bool par_ = (C.bid >> 3) & 1;
        if (par_) { conv_items_f8(C, args, 0, 32); conv_dense(C, args, 3072, 8192); __syncthreads(); }
        pg8::gemm_phase<pg8::EpiBf16S, pg8::StaticOrder, true, true>(ring, g, S, E, C.wave);
        if (!par_) { __syncthreads(); conv_items_f8(C, args, 0, 32); conv_dense(C, args, 3072, 8192); } } }
#endif
    if constexpr (K == 2) { gla_a_phase(C, args); fox_knorm_phase(C); }
    if constexpr (K == 3) { gla_scan_phase(C); __syncthreads(); fox_phase(C); xcd_barrier(bar);
        const int nkv = (C.G >= 128) ? 64 : 0;
        if (C.bid >= C.G - nkv) { pg8::Gemm g{(const bf16*)(ws + WS_MEMN), (const bf16*)(ws + WS_WT_XKV), NB * MEM_LEN, 2 * D, D}; pg8::HalfOrder S{4, 16, C.bid - (C.G - nkv), nkv};
            pg8::EpiBf16S E{(bf16*)(ws + WS_KV2), 2 * D, 1.f, 0, nullptr};
            pg8::gemm_phase<pg8::EpiBf16S, pg8::HalfOrder, true, true, false, true>(ring, g, S, E, C.wave); }
        else gla_c_phase(C, args, C.bid, C.G - nkv);
        if (nkv == 0) { pg8::Gemm g{(const bf16*)(ws + WS_MEMN), (const bf16*)(ws + WS_WT_XKV), NB * MEM_LEN, 2 * D, D}; pg8::HalfOrder S{4, 16, C.bid, C.G};
            pg8::EpiBf16S E{(bf16*)(ws + WS_KV2), 2 * D, 1.f, 0, nullptr}; __syncthreads();
            pg8::gemm_phase<pg8::EpiBf16S, pg8::HalfOrder, true, true, false, true>(ring, g, S, E, C.wave); } }
    if constexpr (K == 4) { pg8::Gemm g{(const bf16*)(ws + WS_CAT), (const bf16*)(ws + WS_WT_OUT), T, D, D, LDP}; pg8::StaticOrder S; S.init(T, D, C.G, C.bid);
        pg8::EpiF32ResNorm E{args.in[I_X], (float*)(ws + WS_H1), D, args.in[I_NORM_XATTN], (unsigned char*)(ws + WS_XN), (float*)(ws + WS_SSP), X8_SCALE};
        pg8::gemm_phase<pg8::EpiF32ResNorm, pg8::StaticOrder, false, true>(ring, g, S, E, C.wave); }
    if constexpr (K == 5) { }
    if constexpr (K == 6) { pg8::Gemm g{(const bf16*)(ws + WS_XN), (const bf16*)(ws + WS_WT_XQ), T, D, D / 2}; pg8::StaticOrder S; S.init(T, D, C.G, C.bid);
        LAS float* rtab = (LAS float*)(C.lds + 131072);
        { pg8::Unit u0; if (S.next(0, u0) && C.tid < 256) { const f32x4* sp = (const f32x4*)((const float*)(ws + WS_SSP) + (size_t)(u0.a128 * 128 + C.tid) * 32); f32x4 t = sp[0];
#pragma unroll
              for (int q = 1; q < 8; ++q) t += sp[q];
              rtab[C.tid] = rsqrtf(((t.x + t.y) + (t.z + t.w)) * (1.f / 2048.f) + EPS); } }
        __syncthreads();
        pg8::EpiBf16S E{(bf16*)(ws + WS_Q2), D, 0.04419417382415922f * 1.4426950408889634f / (X8_SCALE * W8_SCALE), 8, rtab};
        pg8::gemm_phase<pg8::EpiBf16S, pg8::StaticOrder, false, true, true>(ring, g, S, E, C.wave); }
    if constexpr (K == 7) { xattn_phase(C); }
    if constexpr (K == 8) { pg8::Gemm g{(const bf16*)(ws + WS_XO), (const bf16*)(ws + WS_WT_XO), T, D, D / 2}; pg8::StaticOrder S; S.init(T, D, C.G, C.bid);
        pg8::EpiF32Res E{(const float*)(ws + WS_H1), (float*)(ws + WS_H2), D, 1.f / (O8_SCALE * W8_SCALE)};
        pg8::gemm_phase<pg8::EpiF32Res, pg8::StaticOrder, false, true, true>(ring, g, S, E, C.wave); }
    if constexpr (K == 9) { router_phase(C, args); }
    if constexpr (K == 10) { place_phase(C); }
    if constexpr (K == 11) { const int* RT = (const int*)(ws + WS_RT);
        const int nwg_ = __builtin_amdgcn_readfirstlane(RT[0]) * 16;
        pg8::Gemm g{(const bf16*)(ws + WS_XS), (const bf16*)(ws + WS_WT_GU), 0, 2 * DFF, D / 2}; LAS int* utab_ = (LAS int*)(C.lds + LDSCTL_OFF + 1024);
        pg8::MoeOrder S{(const int*)(ws + WS_UL), nwg_, C.G, C.bid, 1, utab_}; S.fill(utab_, C.tid); __syncthreads();
        pg8::EpiGateUp E{(unsigned char*)(ws + WS_HH), DFF, args.in[I_B_GU], 1.f / (X8_SCALE * W8_SCALE), H8_SCALE};
        { const bool par_ = (C.bid >> 3) & 1;
          const int nmax_ = (nwg_ + C.G - 1) / C.G, rem_ = nwg_ - (nmax_ - 1) * C.G; const bool hv_ = 2 * rem_ <= C.G;
          const int X_ = hv_ ? 2 * rem_ : rem_, dp_ = hv_ ? 2 : 3, L256_ = 2048 + dp_ * X_, H256_ = L256_ - 256 * dp_;
          const int c0_ = C.bid, c1_ = C.bid + 1;
          const int cum0_ = c0_ < X_ ? c0_ * H256_ : X_ * H256_ + (c0_ - X_) * L256_, cum1_ = c1_ < X_ ? c1_ * H256_ : X_ * H256_ + (c1_ - X_) * L256_;
          const int s_lo_ = 2 * (cum0_ >> 8), s_hi_ = 2 * (cum1_ >> 8);
          Ctx C2 = C; C2.ngw = 8; C2.gw = 65536 + C.wave;
          const bool conv_ = s_lo_ < s_hi_;
        if (par_) { if (conv_) conv_items_f8(C2, args, s_lo_, s_hi_); __syncthreads(); }
        pg8::gemm_phase<pg8::EpiGateUp, pg8::MoeOrder, true, true, true, true>(ring, g, S, E, C.wave);
        if (!par_) { __syncthreads(); if (conv_) conv_items_f8(C2, args, s_lo_, s_hi_); } } }
    if constexpr (K == 12) { const int* RT = (const int*)(ws + WS_RT);
        pg8::Gemm g{(const bf16*)(ws + WS_HH), (const bf16*)(ws + WS_WT_DN), 0, D, DFF / 2}; LAS int* utab_ = (LAS int*)(C.lds + LDSCTL_OFF + 1024);
        pg8::MoeOrder S{(const int*)(ws + WS_UL) + 8192, __builtin_amdgcn_readfirstlane(RT[0]) * 8, C.G, C.bid, 1, utab_}; S.fill(utab_, C.tid); __syncthreads();
        pg8::EpiDown E{(unsigned char*)(ws + WS_YY), D, args.in[I_B_DN], 1.f / (H8_SCALE * W8_SCALE), Y8_SCALE};
        pg8::gemm_phase<pg8::EpiDown, pg8::MoeOrder, true, true, true, true>(ring, g, S, E, C.wave); }
    if constexpr (K == 13) { final_phase(C, args); }
}

__global__ void __launch_bounds__(NWAVES * 64, 2) mk_fwd(Args args) {
    extern __shared__ __attribute__((aligned(16))) unsigned char lds[];
    Ctx C;
    C.lds = (LAS unsigned char*)lds; C.ws = args.ws;
    C.tid = threadIdx.x; C.lane = C.tid & 63; C.wave = __builtin_amdgcn_readfirstlane(C.tid >> 6);
    C.G = gridDim.x; C.bid = blockIdx.x; C.gw = C.bid * NWAVES + C.wave; C.ngw = C.G * NWAVES;
    volatile LAS unsigned* MISC = (volatile LAS unsigned*)(C.lds + MISC_OFF);
    for (int u = C.tid; u < (LDS_BYTES - LDSCTL_OFF) / 4; u += NWAVES * 64) ((LAS unsigned*)(C.lds + LDSCTL_OFF))[u] = 0u;
    __syncthreads();
    unsigned* ctl = (unsigned*)(args.ws + WS_CTL);
    XcdBarrier bar; bar.bar = ctl + CW_BAR; bar.x = 0; bar.st = nullptr;
    if (MK_N_LAUNCHES == 1) bar = xcd_barrier_post(ctl + CW_BAR, MISC + 8);
    const int lo = args.ph_lo, hi = args.ph_hi;
#define IN(k) (lo <= (k) && (k) < hi)
#define SEAM(k) do { if (IN(k) && IN((k) + 1)) xcd_barrier(bar); } while (0)
    unsigned char* ws = args.ws;
    LAS unsigned char* ring = C.lds + RING_OFF;

#define PH(k) do { if (IN(k)) { run_phase<k>(C, args, bar); if (PROBE_REP == (k)) { xcd_barrier(bar); run_phase<k>(C, args, bar); } } SEAM(k); } while (0)
    PH(0); PH(1); PH(2); PH(3); PH(4); PH(6); PH(7); PH(8); PH(9); PH(10); PH(11); PH(12); PH(13);
#undef PH
#undef IN
#undef SEAM
}

extern "C" void kernel_launch(void* const* d_in, const int* in_sizes, int n_in, void* d_out, int out_size, void* d_ws, size_t ws_size, hipStream_t stream) {
    static int grid = 0;
    if (grid == 0) {
        if (n_in != 22 || out_size != T * D || ws_size < WS_END) { fprintf(stderr, "kernel_launch: unexpected shapes (n_in %d out %d ws %zu need %zu)\n", n_in, out_size, ws_size, (size_t)WS_END); grid = -1; return; }
        int dev = 0, cus = 0, per_cu = 0;
        if (hipGetDevice(&dev) != hipSuccess || hipDeviceGetAttribute(&cus, hipDeviceAttributeMultiprocessorCount, dev) != hipSuccess) { grid = -1; return; }
        if (hipFuncSetAttribute((const void*)mk_fwd, hipFuncAttributeMaxDynamicSharedMemorySize, LDS_BYTES) != hipSuccess) { fprintf(stderr, "kernel_launch: hipFuncSetAttribute failed\n"); grid = -1; return; }
        if (hipOccupancyMaxActiveBlocksPerMultiprocessor(&per_cu, (const void*)mk_fwd, NWAVES * 64, LDS_BYTES) != hipSuccess || per_cu < 1) fprintf(stderr, "kernel_launch: occupancy query says %d\n", per_cu);
        (void)hipGetLastError();
        if (cus != 256) { fprintf(stderr, "kernel_launch: built for a 256-CU MI355X (one workgroup per CU); this device reports %d CUs: nothing launched\n", cus); grid = -1; return; }
        grid = cus;
    }
    if (grid < 0) return;
    if (hipMemsetAsync((char*)d_ws + WS_CTL, 0, CTL_ZERO_BYTES, stream) != hipSuccess) return;
    Args a{};
    for (int i = 0; i < 22; ++i) a.in[i] = (const float*)d_in[i];
    a.out = (float*)d_out; a.ws = (unsigned char*)d_ws;
    if (MK_N_LAUNCHES == 1) { a.ph_lo = 0; a.ph_hi = N_PHASES; hipLaunchKernelGGL(mk_fwd, dim3(grid), dim3(NWAVES * 64), LDS_BYTES, stream, a); }
    else for (int p = 0; p < N_PHASES; ++p) { a.ph_lo = p; a.ph_hi = p + 1; hipLaunchKernelGGL(mk_fwd, dim3(grid), dim3(NWAVES * 64), LDS_BYTES, stream, a); }
}
```

```cpp
#include <hip/hip_runtime.h>
#include <cstdio>
#include <cstdint>
#define GAS __attribute__((address_space(1)))
#define LAS __attribute__((address_space(3)))
__device__ __forceinline__ void glds16s(const void* sbase, unsigned voff, unsigned lds_dst) { unsigned keep;
    asm volatile("s_mov_b32 %0, m0\n\ts_mov_b32 m0, %3\n\ts_nop 0\n\tglobal_load_lds_dwordx4 %1, %2\n\ts_mov_b32 m0, %0" : "=&s"(keep) : "v"(voff), "s"(sbase), "s"(lds_dst) : "memory"); }
__device__ __forceinline__ void glds4s(const void* sbase, unsigned voff, unsigned lds_dst) { unsigned keep;
    asm volatile("s_mov_b32 %0, m0\n\ts_mov_b32 m0, %3\n\ts_nop 0\n\tglobal_load_lds_dword %1, %2\n\ts_mov_b32 m0, %0" : "=&s"(keep) : "v"(voff), "s"(sbase), "s"(lds_dst) : "memory"); }
__device__ __forceinline__ int lane_id() { int r; asm volatile("v_mbcnt_lo_u32_b32 %0, -1, 0\n\tv_mbcnt_hi_u32_b32 %0, -1, %0" : "=v"(r)); return r; }
namespace pg8 {
#define PG8_LAS __attribute__((address_space(3)))
typedef unsigned short bf16_t;
typedef short bf16x8 __attribute__((ext_vector_type(8)));
typedef float f32x4 __attribute__((ext_vector_type(4)));
typedef unsigned u32x4 __attribute__((ext_vector_type(4)));
typedef unsigned u32x2 __attribute__((ext_vector_type(2)));
typedef int v8i32 __attribute__((ext_vector_type(8)));
constexpr int BM = 256, BK = 64, HALF = 128, HTB = HALF * BK * 2  , STAGE_BYTES = 8 * HTB, NXCD = 8, WGM = 8;

__host__ __device__ __forceinline__ int lds_byte(int r, int c) { const int st = (r >> 4) * 2 + (c >> 5), rr = r & 15, cc = c & 31, ob = rr * 64 + cc * 2; return st * 1024 + (ob ^ (((ob >> 9) & 1) << 5)); }
__host__ __device__ __forceinline__ void stage_rc(int b, int& R, int& C) { const int st = b / 1024, sb = b % 1024, swz = sb ^ (((sb >> 9) & 1) << 5); R = (st >> 1) * 16 + swz / 64; C = (st & 1) * 32 + (swz % 64) / 2; }
__host__ __device__ __forceinline__ int perm32(int rho) { const int n = rho >> 4, i = rho & 15; return 8 * (i >> 2) + 4 * n + (i & 3); }

struct Unit { int pn, a128, nrows; };
struct Gemm { const bf16_t* A; const bf16_t* Bt; int M, N, K; int ld = 0; };

struct StaticOrder {
    int nM, nN, nwg, G, c;
    __host__ __device__ void init(int M, int N, int G_, int c_) { nM = M / BM; nN = N / BM; nwg = nM * nN; G = G_; c = c_; }
    __host__ __device__ bool next(int i, Unit& u) const {
        const long L = (long)i * G + c; if (L >= nwg) return false;
        int wgid = (int)L; { const int q = nwg / NXCD, r = nwg % NXCD, xcd = wgid % NXCD, off = wgid / NXCD; wgid = (xcd < r ? xcd * (q + 1) : r * (q + 1) + (xcd - r) * q) + off; }
        const int nig = WGM * nN, gid = wgid / nig, fm = gid * WGM, gsz = (nM - fm) < WGM ? (nM - fm) : WGM;
        u.a128 = 2 * (fm + ((wgid % nig) % gsz)); u.pn = (wgid % nig) / gsz; u.nrows = 256; return true;
    }
    __device__ __forceinline__ void a_ready(const Unit&) const {}
    __device__ __forceinline__ void done(const Unit&) const {}
};
struct HalfOrder {
    int nrb, nN, first, stride;
    __device__ __forceinline__ bool next(int i, Unit& u) const { const int L = first + i * stride; if (L < 0 || L >= nrb * nN) return false; u.a128 = L % nrb; u.pn = L / nrb; u.nrows = 128; return true; }
    __device__ __forceinline__ void a_ready(const Unit&) const {}
    __device__ __forceinline__ void done(const Unit&) const {}
};
struct MoeOrder {
    const int* ul; int nwg, G, c, split; const PG8_LAS int* tab; int lo = 0, hi = 16;
    __device__ __forceinline__ bool raw(int i, int& a128, int& nrows, int& pn) const {
        int L = i * G + c; const int rem = nwg - i * G;
        const bool halves = split && rem > 0 && 2 * rem <= G;
        if (halves) { if (c >= 2 * rem) return false; L = i * G + (c >> 1); }
        if (L >= nwg) return false;
        int wgid = L; { const int q = nwg / NXCD, r = nwg % NXCD, xcd = wgid % NXCD, off = wgid / NXCD; wgid = (xcd < r ? xcd * (q + 1) : r * (q + 1) + (xcd - r) * q) + off; }
        a128 = ul[3 * wgid]; nrows = ul[3 * wgid + 1]; pn = ul[3 * wgid + 2];
        if (halves) { if (c & 1) { if (nrows <= 128) return false; a128 += 1; nrows -= 128; } else if (nrows > 128) nrows = 128; }
        return true;
    }
    __device__ __forceinline__ void fill(PG8_LAS int* t, int tid) const {
        if (tid < 16) { int a = 0, n = 0, p = 0; const bool ok = raw(tid, a, n, p); t[4 * tid] = ok ? 1 : 0; t[4 * tid + 1] = a; t[4 * tid + 2] = n; t[4 * tid + 3] = p; }
    }
    __device__ __forceinline__ bool next(int i, Unit& u) const {
        if (i + lo >= hi) return false;
        const PG8_LAS int* e = tab + 4 * (i + lo);
        const int ok = __builtin_amdgcn_readfirstlane(e[0]); u.a128 = __builtin_amdgcn_readfirstlane(e[1]); u.nrows = __builtin_amdgcn_readfirstlane(e[2]); u.pn = __builtin_amdgcn_readfirstlane(e[3]);
        return ok != 0;
    }
    __device__ __forceinline__ void a_ready(const Unit&) const {}
    __device__ __forceinline__ void done(const Unit&) const {}
};
__device__ __forceinline__ unsigned cvt_pk_bf16(float lo, float hi) { unsigned r; asm volatile("v_cvt_pk_bf16_f32 %0, %1, %2" : "=v"(r) : "v"(lo), "v"(hi)); return r; }
struct EpiBf16S {
    static constexpr bool PERM = true, AFTER_DRAIN = false;
    bf16_t* O; int ldc; float scale; int nsc; const PG8_LAS float* rstd;
    __device__ __forceinline__ void operator()(const f32x4 (&acc)[2][2][4][2], const Unit& u, int wr, int wc, int fr, int fq) const {
        asm volatile("" : "+v"(fr), "+v"(fq));
        const int lrow0 = wr * 64 + fr; const int row0 = u.a128 * 128 + lrow0; const int col0 = u.pn * BM + wc * 32 + 8 * fq;
        const float sc = (u.pn < nsc) ? scale : 1.f;
#pragma unroll
        for (int ai = 0; ai < 2; ++ai)
#pragma unroll
            for (int m = 0; m < 4; ++m) { if (lrow0 + ai * HALF + m * 16 < u.nrows) { bf16_t* rowp = O + (size_t)(row0 + ai * HALF + m * 16) * ldc + col0;
                float rs = sc; if (rstd) rs *= rstd[lrow0 + ai * HALF + m * 16];
#pragma unroll
                for (int bj = 0; bj < 2; ++bj) { const f32x4 v0 = acc[ai][bj][m][0] * rs, v1 = acc[ai][bj][m][1] * rs;
                    u32x4 w; w.x = cvt_pk_bf16(v0[0], v0[1]); w.y = cvt_pk_bf16(v0[2], v0[3]); w.z = cvt_pk_bf16(v1[0], v1[1]); w.w = cvt_pk_bf16(v1[2], v1[3]);
                    *(u32x4*)(rowp + bj * HALF) = w; } } }
    }
};
struct EpiF32ResNorm {
    static constexpr bool PERM = false, AFTER_DRAIN = false;
    const float* base; float* out; int ldc; const float* gain; unsigned char* XG; float* SSP; float xscale;
    __device__ __forceinline__ void operator()(const f32x4 (&acc)[2][2][4][2], const Unit& u, int wr, int wc, int fr, int fq) const {
        asm volatile("" : "+v"(fr), "+v"(fq));
        const int row0 = u.a128 * 128 + wr * 64 + fr; const int col0 = u.pn * BM + wc * 32 + 4 * fq;
        f32x4 gv[2][2];
#pragma unroll
        for (int bj = 0; bj < 2; ++bj)
#pragma unroll
            for (int n = 0; n < 2; ++n) gv[bj][n] = *(const f32x4*)(gain + col0 + bj * HALF + n * 16);
#pragma unroll
        for (int ai = 0; ai < 2; ++ai) {
            f32x4 pre[4][2][2];
#pragma unroll
            for (int m = 0; m < 4; ++m) { const size_t off = (size_t)(row0 + ai * HALF + m * 16) * ldc + col0;
#pragma unroll
                for (int bj = 0; bj < 2; ++bj)
#pragma unroll
                    for (int n = 0; n < 2; ++n) pre[m][bj][n] = *(const f32x4*)(base + off + bj * HALF + n * 16); }
#pragma unroll
            for (int m = 0; m < 4; ++m) { const int row = row0 + ai * HALF + m * 16; const size_t off = (size_t)row * ldc + col0; float ss = 0.f;
#pragma unroll
                for (int bj = 0; bj < 2; ++bj)
#pragma unroll
                    for (int n = 0; n < 2; ++n) { const f32x4 o = pre[m][bj][n] + acc[ai][bj][m][n];
                        *(f32x4*)(out + off + bj * HALF + n * 16) = o; ss += (o.x * o.x + o.y * o.y) + (o.z * o.z + o.w * o.w);
                        const f32x4 y = o * gv[bj][n] * xscale; int w = 0; w = __builtin_amdgcn_cvt_pk_fp8_f32(y.x, y.y, w, false); w = __builtin_amdgcn_cvt_pk_fp8_f32(y.z, y.w, w, true); *(int*)(XG + off + bj * HALF + n * 16) = w; }
                ss += __shfl_xor(ss, 16); ss += __shfl_xor(ss, 32);
                if (fq == 0) SSP[(size_t)row * 32 + u.pn * 4 + wc] = ss; }
        }
    }
};
struct EpiF32Res {
    static constexpr bool PERM = false, AFTER_DRAIN = false;
    const float* base; float* out; int ldc; float ascale;
    __device__ __forceinline__ void operator()(const f32x4 (&acc)[2][2][4][2], const Unit& u, int wr, int wc, int fr, int fq) const {
        asm volatile("" : "+v"(fr), "+v"(fq));
        const int row0 = u.a128 * 128 + wr * 64 + fr; const int col0 = u.pn * BM + wc * 32 + 4 * fq;
#pragma unroll
        for (int ai = 0; ai < 2; ++ai) {
            f32x4 pre[4][2][2];
#pragma unroll
            for (int m = 0; m < 4; ++m) { const size_t off = (size_t)(row0 + ai * HALF + m * 16) * ldc + col0;
#pragma unroll
                for (int bj = 0; bj < 2; ++bj)
#pragma unroll
                    for (int n = 0; n < 2; ++n) pre[m][bj][n] = *(const f32x4*)(base + off + bj * HALF + n * 16); }
#pragma unroll
            for (int m = 0; m < 4; ++m) { const size_t off = (size_t)(row0 + ai * HALF + m * 16) * ldc + col0;
#pragma unroll
                for (int bj = 0; bj < 2; ++bj)
#pragma unroll
                    for (int n = 0; n < 2; ++n) *(f32x4*)(out + off + bj * HALF + n * 16) = pre[m][bj][n] + acc[ai][bj][m][n] * ascale; }
        }
    }
};
struct EpiGateUp {
    static constexpr bool PERM = true, AFTER_DRAIN = false;
    unsigned char* H; int ldh; const float* bias; float ascale, oscale;
    static __device__ __forceinline__ float act(float g, float uu) {
        g = fminf(g, 7.f); uu = fminf(fmaxf(uu, -7.f), 7.f);
        const float s = __builtin_amdgcn_rcpf(1.f + __builtin_amdgcn_exp2f(-1.702f * 1.4426950408889634f * g)); return (uu + 1.f) * (g * s);
    }
    __device__ __forceinline__ void operator()(const f32x4 (&acc)[2][2][4][2], const Unit& u, int wr, int wc, int fr, int fq) const {
        asm volatile("" : "+v"(fr), "+v"(fq));
        const int lrow0 = wr * 64 + fr; const int lcol0 = wc * 32 + 8 * fq;
        const int ue = u.pn >> 4, upnl = u.pn & 15;
        const float* bp = bias + (size_t)ue * 4096 + upnl * BM + lcol0;
        f32x4 bv[2][2];
#pragma unroll
        for (int bj = 0; bj < 2; ++bj)
#pragma unroll
            for (int n = 0; n < 2; ++n) bv[bj][n] = *(const f32x4*)(bp + bj * HALF + 4 * n);
        asm volatile("" : "+v"(bv[0][0]), "+v"(bv[0][1]), "+v"(bv[1][0]), "+v"(bv[1][1]));
#pragma unroll
        for (int ai = 0; ai < 2; ++ai)
#pragma unroll
            for (int m = 0; m < 4; ++m) { const int lr = lrow0 + ai * HALF + m * 16;
                if (lr < u.nrows) { unsigned char* rowp = H + (size_t)(u.a128 * 128 + lr) * ldh + upnl * 128 + (lcol0 >> 1);
#pragma unroll
                    for (int bj = 0; bj < 2; ++bj) { const f32x4 v0 = acc[ai][bj][m][0] * ascale + bv[bj][0], v1 = acc[ai][bj][m][1] * ascale + bv[bj][1];
                        int w = 0; w = __builtin_amdgcn_cvt_pk_fp8_f32(act(v0[0], v0[1]) * oscale, act(v0[2], v0[3]) * oscale, w, false);
                        w = __builtin_amdgcn_cvt_pk_fp8_f32(act(v1[0], v1[1]) * oscale, act(v1[2], v1[3]) * oscale, w, true);
                        *(int*)(rowp + bj * 64) = w; } } }
    }
};
struct EpiDown {
    static constexpr bool PERM = true, AFTER_DRAIN = false;
    unsigned char* Y; int ldy; const float* bias; float ascale, yscale;
    __device__ __forceinline__ void operator()(const f32x4 (&acc)[2][2][4][2], const Unit& u, int wr, int wc, int fr, int fq) const {
        asm volatile("" : "+v"(fr), "+v"(fq));
        const int ue = u.pn >> 3, upnl = u.pn & 7;
        const int lrow0 = wr * 64 + fr; const int lcol0 = upnl * BM + wc * 32 + 8 * fq;
        const float* bp = bias + (size_t)ue * 2048 + lcol0;
        f32x4 bv[2][2];
#pragma unroll
        for (int bj = 0; bj < 2; ++bj)
#pragma unroll
            for (int n = 0; n < 2; ++n) bv[bj][n] = *(const f32x4*)(bp + bj * HALF + 4 * n);
        asm volatile("" : "+v"(bv[0][0]), "+v"(bv[0][1]), "+v"(bv[1][0]), "+v"(bv[1][1]));
#pragma unroll
        for (int ai = 0; ai < 2; ++ai)
#pragma unroll
            for (int m = 0; m < 4; ++m) { const int lr = lrow0 + ai * HALF + m * 16;
                if (lr < u.nrows) { unsigned char* rowp = Y + (size_t)(u.a128 * 128 + lr) * ldy + lcol0;
#pragma unroll
                    for (int bj = 0; bj < 2; ++bj) { const f32x4 v0 = (acc[ai][bj][m][0] * ascale + bv[bj][0]) * yscale, v1 = (acc[ai][bj][m][1] * ascale + bv[bj][1]) * yscale;
                        int w0 = 0, w1 = 0; w0 = __builtin_amdgcn_cvt_pk_fp8_f32(v0[0], v0[1], w0, false); w0 = __builtin_amdgcn_cvt_pk_fp8_f32(v0[2], v0[3], w0, true);
                        w1 = __builtin_amdgcn_cvt_pk_fp8_f32(v1[0], v1[1], w1, false); w1 = __builtin_amdgcn_cvt_pk_fp8_f32(v1[2], v1[3], w1, true);
                        u32x2 w; w.x = (unsigned)w0; w.y = (unsigned)w1; *(u32x2*)(rowp + bj * HALF) = w; } } }
    }
};
template <class Epi, class Sched, bool ALIGN_EPI = false, bool SP2 = false, bool FP8 = false, bool HALF_OK = false>
__device__ __forceinline__ void gemm_phase(PG8_LAS unsigned char* lds, const Gemm g, const Sched& S, const Epi& E, const int wid  ) {
    const int lane = lane_id(), tid = wid * 64 + lane, wr = wid >> 2, wc = wid & 3, fr = lane & 15, fq = lane >> 4;
    const int K = g.K, nt = K / BK, LD = g.ld ? g.ld : g.K;
    unsigned voffA[2], voffB[2];
#pragma unroll
    for (int i = 0; i < 2; ++i) { int R, C; stage_rc(tid * 16 + i * 8192, R, C); const int Rb = Epi::PERM ? ((R & ~31) + perm32(R & 31)) : R;
        voffA[i] = (unsigned)(R * LD + C) * 2u; voffB[i] = (unsigned)(Rb * LD + C) * 2u; }
    const size_t kstep = (size_t)(BK * 2);
    const size_t hstep = (size_t)HALF * LD * 2;
    const size_t tstep = 2 * hstep;
    const unsigned ldsw = (unsigned)wid * 1024u;
    const unsigned ldsb = (unsigned)(unsigned long long)lds + ldsw;
    const int aoff = lds_byte(wr * 64 + fr, fq * 8), boff = lds_byte(wc * 32 + fr, fq * 8);
#define PG8_SA(b, h) (((b) * 2 + (h)) * HTB)
#define PG8_SB(b, h) ((4 + (b) * 2 + (h)) * HTB)
#define PG8_STAGE(bufoff, gbase, voff) do { _Pragma("unroll") for (int _i = 0; _i < 2; ++_i) \
        glds16s((const void*)(gbase), (voff)[_i], ldsb + (unsigned)((bufoff) + _i * 8192)); } while (0)
#define PG8_LDA(dst, b, h) do { _Pragma("unroll") for (int m = 0; m < 4; ++m) _Pragma("unroll") for (int k = 0; k < 2; ++k) dst[m][k] = *(const PG8_LAS bf16x8*)(lds + PG8_SA(b, h) + aoff + m * 2048 + k * 1024); } while (0)
#define PG8_LDB(dst, b, h) do { _Pragma("unroll") for (int n = 0; n < 2; ++n) _Pragma("unroll") for (int k = 0; k < 2; ++k) dst[n][k] = *(const PG8_LAS bf16x8*)(lds + PG8_SB(b, h) + boff + n * 2048 + k * 1024); } while (0)
#define PG8_MMA(ai, bj, At, Bt) do { __builtin_amdgcn_s_setprio(1); _Pragma("unroll") for (int m = 0; m < 4; ++m) _Pragma("unroll") for (int n = 0; n < 2; ++n) { \
        if constexpr (FP8) { acc[ai][bj][m][n] = __builtin_amdgcn_mfma_scale_f32_16x16x128_f8f6f4(__builtin_bit_cast(v8i32, __builtin_shufflevector(Bt[n][0], Bt[n][1], 0, 1, 2, 3, 4, 5, 6, 7, 8, 9, 10, 11, 12, 13, 14, 15)), \
                __builtin_bit_cast(v8i32, __builtin_shufflevector(At[m][0], At[m][1], 0, 1, 2, 3, 4, 5, 6, 7, 8, 9, 10, 11, 12, 13, 14, 15)), acc[ai][bj][m][n], 0, 0, 0, 0x7F7F7F7F, 0, 0x7F7F7F7F); } \
        else { _Pragma("unroll") for (int k = 0; k < 2; ++k) acc[ai][bj][m][n] = __builtin_amdgcn_mfma_f32_16x16x32_bf16(Bt[n][k], At[m][k], acc[ai][bj][m][n], 0, 0, 0); } } \
        __builtin_amdgcn_s_setprio(0); } while (0)
#define PG8_WAIT_V(n) asm volatile("s_waitcnt vmcnt(" #n ")" ::: "memory")
#define PG8_WAIT_L(n) asm volatile("s_waitcnt lgkmcnt(" #n ")" ::: "memory")
#define PG8_BAR __builtin_amdgcn_s_barrier()
#define PG8_SCHED __builtin_amdgcn_sched_barrier(0)
    Unit cur, nxt; int ui = 0;
    if (!S.next(0, cur)) return;
    f32x4 acc[2][2][4][2];
#pragma unroll
    for (int a = 0; a < 2; ++a)
#pragma unroll
        for (int b = 0; b < 2; ++b)
#pragma unroll
            for (int m = 0; m < 4; ++m)
#pragma unroll
                for (int n = 0; n < 2; ++n) acc[a][b][m][n] = (f32x4){0.f, 0.f, 0.f, 0.f};
    bf16x8 At[4][2], B0[2][2], B1[2][2];
    const char* cA = (const char*)g.A + (size_t)cur.a128 * hstep; const char* cB = (const char*)g.Bt + (size_t)cur.pn * tstep;
    S.a_ready(cur);
    if constexpr (SP2) {
        PG8_STAGE(PG8_SB(0, 0), cB, voffB); PG8_STAGE(PG8_SB(0, 1), cB + hstep, voffB); PG8_STAGE(PG8_SA(0, 0), cA, voffA); PG8_STAGE(PG8_SA(0, 1), cA + hstep, voffA);
        if (wr == 1) PG8_BAR;
        PG8_WAIT_V(2); PG8_BAR;
        PG8_STAGE(PG8_SB(1, 0), cB + kstep, voffB); PG8_STAGE(PG8_SA(1, 0), cA + kstep, voffA); PG8_STAGE(PG8_SB(1, 1), cB + hstep + kstep, voffB);
        PG8_WAIT_V(6); PG8_BAR;
    } else {
        PG8_STAGE(PG8_SB(0, 0), cB, voffB); PG8_STAGE(PG8_SA(0, 0), cA, voffA); PG8_STAGE(PG8_SB(0, 1), cB + hstep, voffB); PG8_STAGE(PG8_SA(0, 1), cA + hstep, voffA);
        if (wr == 1) PG8_BAR;
        PG8_WAIT_V(4); PG8_BAR;
        PG8_STAGE(PG8_SB(1, 0), cB + kstep, voffB); PG8_STAGE(PG8_SA(1, 0), cA + kstep, voffA); PG8_STAGE(PG8_SB(1, 1), cB + hstep + kstep, voffB);
        PG8_WAIT_V(6); PG8_BAR;
    }
    for (;;) {
        const bool has_next = S.next(ui + 1, nxt); const bool full = HALF_OK ? (cur.nrows > 128) : true;
        const char* nA = has_next ? (const char*)g.A + (size_t)nxt.a128 * hstep : cA; const char* nB = has_next ? (const char*)g.Bt + (size_t)nxt.pn * tstep : cB;
        if (!HALF_OK || full) {
        for (int t = 0; t < nt; t += 2) {
            const bool last = (t == nt - 2);
            const char* a1 = cA + (size_t)(t + 1) * kstep;
            const char* a2 = last ? nA : cA + (size_t)(t + 2) * kstep; const char* b2 = last ? nB : cB + (size_t)(t + 2) * kstep;
            const char* a3 = a2 + kstep; const char* b3 = b2 + kstep;
            if (last && has_next) S.a_ready(nxt);
            if constexpr (SP2) {
            PG8_LDB(B0, 0, 0); PG8_LDB(B1, 0, 1); PG8_SCHED; PG8_LDA(At, 0, 0); PG8_STAGE(PG8_SA(1, 1), a1 + hstep, voffA);
            PG8_WAIT_V(8); PG8_WAIT_L(0); PG8_BAR; PG8_MMA(0, 0, At, B0); PG8_MMA(0, 1, At, B1); PG8_BAR; PG8_SCHED;
            PG8_LDA(At, 0, 1); PG8_STAGE(PG8_SB(0, 0), b2, voffB); PG8_STAGE(PG8_SB(0, 1), b2 + hstep, voffB); PG8_STAGE(PG8_SA(0, 0), a2, voffA);
            PG8_WAIT_V(8); PG8_WAIT_L(0); PG8_BAR; if (true) { PG8_MMA(1, 0, At, B0); PG8_MMA(1, 1, At, B1); } PG8_BAR; PG8_SCHED;
            PG8_LDB(B0, 1, 0); PG8_LDB(B1, 1, 1); PG8_SCHED; PG8_LDA(At, 1, 0); PG8_STAGE(PG8_SA(0, 1), a2 + hstep, voffA);
            PG8_WAIT_V(8); PG8_WAIT_L(0); PG8_BAR; PG8_MMA(0, 0, At, B0); PG8_MMA(0, 1, At, B1); PG8_BAR; PG8_SCHED;
            PG8_LDA(At, 1, 1); PG8_STAGE(PG8_SB(1, 0), b3, voffB); PG8_STAGE(PG8_SB(1, 1), b3 + hstep, voffB); PG8_STAGE(PG8_SA(1, 0), a3, voffA);
            PG8_WAIT_V(8); PG8_WAIT_L(0); PG8_BAR; if (true) { PG8_MMA(1, 0, At, B0); PG8_MMA(1, 1, At, B1); } PG8_BAR; PG8_SCHED;
            } else {
            PG8_LDB(B0, 0, 0); PG8_SCHED; PG8_LDA(At, 0, 0); PG8_STAGE(PG8_SA(1, 1), a1 + hstep, voffA);
            PG8_WAIT_L(8); PG8_BAR; PG8_WAIT_L(0); PG8_MMA(0, 0, At, B0); PG8_BAR; PG8_SCHED;
            PG8_LDB(B1, 0, 1); PG8_STAGE(PG8_SB(0, 0), b2, voffB);
            PG8_BAR; PG8_WAIT_L(0); PG8_MMA(0, 1, At, B1); PG8_BAR;
            PG8_LDA(At, 0, 1); PG8_STAGE(PG8_SA(0, 0), a2, voffA);
            PG8_BAR; PG8_WAIT_L(0); if (true) PG8_MMA(1, 0, At, B0); PG8_BAR; PG8_SCHED;
            PG8_STAGE(PG8_SB(0, 1), b2 + hstep, voffB);
            PG8_WAIT_V(6); PG8_BAR; if (true) PG8_MMA(1, 1, At, B1); PG8_BAR;
            PG8_LDB(B0, 1, 0); PG8_SCHED; PG8_LDA(At, 1, 0); PG8_STAGE(PG8_SA(0, 1), a2 + hstep, voffA);
            PG8_WAIT_L(8); PG8_BAR; PG8_WAIT_L(0); PG8_MMA(0, 0, At, B0); PG8_BAR; PG8_SCHED;
            PG8_LDB(B1, 1, 1); PG8_STAGE(PG8_SB(1, 0), b3, voffB);
            PG8_BAR; PG8_WAIT_L(0); PG8_MMA(0, 1, At, B1); PG8_BAR;
            PG8_LDA(At, 1, 1); PG8_STAGE(PG8_SA(1, 0), a3, voffA);
            PG8_BAR; PG8_WAIT_L(0); if (true) PG8_MMA(1, 0, At, B0); PG8_BAR; PG8_SCHED;
            PG8_STAGE(PG8_SB(1, 1), b3 + hstep, voffB);
            PG8_WAIT_V(6); PG8_BAR; if (true) PG8_MMA(1, 1, At, B1); PG8_BAR;
            }
        }
        } else {
        for (int t = 0; t < nt; t += 2) {
            const bool last = (t == nt - 2);
            const char* a1 = cA + (size_t)(t + 1) * kstep;
            const char* a2 = last ? nA : cA + (size_t)(t + 2) * kstep; const char* b2 = last ? nB : cB + (size_t)(t + 2) * kstep;
            const char* a3 = a2 + kstep; const char* b3 = b2 + kstep;
            if (last && has_next) S.a_ready(nxt);
            if constexpr (SP2) {
            PG8_LDB(B0, 0, 0); PG8_LDB(B1, 0, 1); PG8_SCHED; PG8_LDA(At, 0, 0); PG8_STAGE(PG8_SA(1, 1), a1 + hstep, voffA);
            PG8_WAIT_V(8); PG8_WAIT_L(0); PG8_BAR; PG8_MMA(0, 0, At, B0); PG8_MMA(0, 1, At, B1); PG8_BAR; PG8_SCHED;
            PG8_LDA(At, 0, 1); PG8_STAGE(PG8_SB(0, 0), b2, voffB); PG8_STAGE(PG8_SB(0, 1), b2 + hstep, voffB); PG8_STAGE(PG8_SA(0, 0), a2, voffA);
            PG8_WAIT_V(8); PG8_WAIT_L(0); PG8_BAR; if (false) { PG8_MMA(1, 0, At, B0); PG8_MMA(1, 1, At, B1); } PG8_BAR; PG8_SCHED;
            PG8_LDB(B0, 1, 0); PG8_LDB(B1, 1, 1); PG8_SCHED; PG8_LDA(At, 1, 0); PG8_STAGE(PG8_SA(0, 1), a2 + hstep, voffA);
            PG8_WAIT_V(8); PG8_WAIT_L(0); PG8_BAR; PG8_MMA(0, 0, At, B0); PG8_MMA(0, 1, At, B1); PG8_BAR; PG8_SCHED;
            PG8_LDA(At, 1, 1); PG8_STAGE(PG8_SB(1, 0), b3, voffB); PG8_STAGE(PG8_SB(1, 1), b3 + hstep, voffB); PG8_STAGE(PG8_SA(1, 0), a3, voffA);
            PG8_WAIT_V(8); PG8_WAIT_L(0); PG8_BAR; if (false) { PG8_MMA(1, 0, At, B0); PG8_MMA(1, 1, At, B1); } PG8_BAR; PG8_SCHED;
            } else {
            PG8_LDB(B0, 0, 0); PG8_SCHED; PG8_LDA(At, 0, 0); PG8_STAGE(PG8_SA(1, 1), a1 + hstep, voffA);
            PG8_WAIT_L(8); PG8_BAR; PG8_WAIT_L(0); PG8_MMA(0, 0, At, B0); PG8_BAR; PG8_SCHED;
            PG8_LDB(B1, 0, 1); PG8_STAGE(PG8_SB(0, 0), b2, voffB);
            PG8_BAR; PG8_WAIT_L(0); PG8_MMA(0, 1, At, B1); PG8_BAR;
            PG8_LDA(At, 0, 1); PG8_STAGE(PG8_SA(0, 0), a2, voffA);
            PG8_BAR; PG8_WAIT_L(0); if (false) PG8_MMA(1, 0, At, B0); PG8_BAR; PG8_SCHED;
            PG8_STAGE(PG8_SB(0, 1), b2 + hstep, voffB);
            PG8_WAIT_V(6); PG8_BAR; if (false) PG8_MMA(1, 1, At, B1); PG8_BAR;
            PG8_LDB(B0, 1, 0); PG8_SCHED; PG8_LDA(At, 1, 0); PG8_STAGE(PG8_SA(0, 1), a2 + hstep, voffA);
            PG8_WAIT_L(8); PG8_BAR; PG8_WAIT_L(0); PG8_MMA(0, 0, At, B0); PG8_BAR; PG8_SCHED;
            PG8_LDB(B1, 1, 1); PG8_STAGE(PG8_SB(1, 0), b3, voffB);
            PG8_BAR; PG8_WAIT_L(0); PG8_MMA(0, 1, At, B1); PG8_BAR;
            PG8_LDA(At, 1, 1); PG8_STAGE(PG8_SA(1, 0), a3, voffA);
            PG8_BAR; PG8_WAIT_L(0); if (false) PG8_MMA(1, 0, At, B0); PG8_BAR; PG8_SCHED;
            PG8_STAGE(PG8_SB(1, 1), b3 + hstep, voffB);
            PG8_WAIT_V(6); PG8_BAR; if (false) PG8_MMA(1, 1, At, B1); PG8_BAR;
            }
        }
        }
        if constexpr (ALIGN_EPI) { if (wr == 0) PG8_BAR; }
        if constexpr (!Epi::AFTER_DRAIN) { int t2_ = lane_id(); asm volatile("" : "+v"(t2_)); E(acc, cur, wr, wc, t2_ & 15, t2_ >> 4); S.done(cur); }
        if (!has_next) break;
#pragma unroll
        for (int a = 0; a < 2; ++a)
#pragma unroll
            for (int b = 0; b < 2; ++b)
#pragma unroll
                for (int m = 0; m < 4; ++m)
#pragma unroll
                    for (int n = 0; n < 2; ++n) acc[a][b][m][n] = (f32x4){0.f, 0.f, 0.f, 0.f};
        cur = nxt; cA = nA; cB = nB; ++ui;
        if constexpr (ALIGN_EPI) { if (wr == 1) PG8_BAR; }
    }
    PG8_WAIT_V(0);
    if constexpr (!ALIGN_EPI) { if (wr == 0) PG8_BAR; }
    PG8_BAR;
    if constexpr (Epi::AFTER_DRAIN) { E.fused(acc, cur, wr, wc, fr, fq, lds, wid, lane); S.done(cur); }
#undef PG8_SA
#undef PG8_SB
#undef PG8_STAGE
#undef PG8_LDA
#undef PG8_LDB
#undef PG8_MMA
#undef PG8_WAIT_V
#undef PG8_WAIT_L
#undef PG8_BAR
#undef PG8_SCHED
}
}
#define XB_TMO      128
#define XB_XCNT(j)  (256  + 64 * (j))
#define XB_XSUB(j)  (1280 + 64 * (j))
#define XB_XGEN(j)  (2304 + 64 * (j))
#define XB_TOP      3328
#define XB_TOPGEN   3392
#define XCD_BAR_WORDS 3456
#define XB_SPIN_CAP (1u << 18)

__device__ __forceinline__ unsigned xb_ld(unsigned* p)              { return __hip_atomic_load(p, __ATOMIC_RELAXED, __HIP_MEMORY_SCOPE_AGENT); }
__device__ __forceinline__ unsigned xb_add(unsigned* p, unsigned v) { return __hip_atomic_fetch_add(p, v, __ATOMIC_RELAXED, __HIP_MEMORY_SCOPE_AGENT); }
__device__ __forceinline__ unsigned xb_xcc_id() { return (unsigned)__builtin_amdgcn_s_getreg((3 << 11) | 20) & 0xFu; }
#define XB_SPIN(cond, bar) do { unsigned _sp = 0; while (cond) { __builtin_amdgcn_s_sleep(1); \
    if ((++_sp & 255u) == 0u) { if (xb_ld(&(bar)[XB_TMO])) break; if (_sp > XB_SPIN_CAP) { atomicAdd(&(bar)[XB_TMO], 1u); break; } } } } while (0)

struct XcdBarrier {
    unsigned* bar; unsigned x;
    volatile LAS unsigned* st;
};

__device__ __forceinline__ XcdBarrier xcd_barrier_post(unsigned* bar, volatile LAS unsigned* st) {
    XcdBarrier b; b.bar = bar; b.x = xb_xcc_id(); b.st = st;
    if (threadIdx.x == 0) (void)xb_add(&bar[XB_XCNT(b.x)], 1u);
    return b;
}
__device__ __forceinline__ void xcd_barrier_complete(unsigned* bar, unsigned x, unsigned& nloc, unsigned& nx) {
    const unsigned G = gridDim.x * gridDim.y * gridDim.z;
    unsigned sum, cnt, mine, sp = 0u;
    for (;;) {
        sum = 0u; cnt = 0u; mine = 0u;
#pragma unroll
        for (unsigned j = 0; j < 16; ++j) { const unsigned c = xb_ld(&bar[XB_XCNT(j)]); sum += c; cnt += (c > 0u) ? 1u : 0u; mine = (j == x) ? c : mine; }
        if (sum == G) break;
        __builtin_amdgcn_s_sleep(1);
        if ((++sp & 255u) == 0u) { if (xb_ld(&bar[XB_TMO])) break; if (sp > XB_SPIN_CAP) { atomicAdd(&bar[XB_TMO], 1u); break; } }
    }
    nloc = mine > 0u ? mine : 1u; nx = cnt > 0u ? cnt : 1u;
}

__device__ __forceinline__ void xcd_barrier(const XcdBarrier& b) {
    asm volatile("s_waitcnt vmcnt(0)" ::: "memory");
    __syncthreads();
    if (threadIdx.x == 0) {
        unsigned* bar = b.bar;
        __builtin_amdgcn_s_waitcnt(0);
        unsigned nloc = b.st[0], nx = b.st[1];
        if (nloc == 0u) { xcd_barrier_complete(bar, b.x, nloc, nx); b.st[0] = nloc; b.st[1] = nx; }
        const unsigned old = xb_add(&bar[XB_XSUB(b.x)], 1u);
        const unsigned gen = old / nloc;
        if (old + 1u == (gen + 1u) * nloc) {
            __builtin_amdgcn_fence(__ATOMIC_RELEASE, "agent");
            asm volatile("s_waitcnt vmcnt(0)" ::: "memory");
            const unsigned og = xb_add(&bar[XB_TOP], 1u);
            const unsigned tg = og / nx;
            if (og + 1u == (tg + 1u) * nx) xb_add(&bar[XB_TOPGEN], 1u);
            else XB_SPIN(xb_ld(&bar[XB_TOPGEN]) == tg, bar);
            __builtin_amdgcn_fence(__ATOMIC_ACQUIRE, "agent");
            xb_add(&bar[XB_XGEN(b.x)], 1u);
            asm volatile("s_waitcnt vmcnt(0)" ::: "memory");
        } else {
            XB_SPIN(xb_ld(&bar[XB_XGEN(b.x)]) == gen, bar);
            __builtin_amdgcn_fence(__ATOMIC_ACQUIRE, "agent");
            asm volatile("s_waitcnt vmcnt(0)" ::: "memory");
        }
    }
    __syncthreads();
}
constexpr int NWAVES = 8;
constexpr int NB = 2, SEQ = 4096, T = NB * SEQ, D = 2048;
constexpr int W_IN_LD = 6168, PROJ_N = 6144;
constexpr int PJ_GQ = 0, PJ_GK = 512, PJ_GV = 1024, PJ_GR = 2048, PJ_FQ = 3072, PJ_FK = 4096, PJ_FV = 5120;
constexpr int WIN_GA = 3072, WIN_FF = 6160;
constexpr int GLA_H = 4, GLA_DK = 128, GLA_DV = 256, FOX_H = 8, FOX_DH = 128;
constexpr int MEM_LEN = 256, XH = 4, XDH = 512;
constexpr int NE = 32, TOPK = 4, DFF = 2048;
constexpr int XS_ROWS = 37120;
constexpr float EPS = 1e-6f;
constexpr int LDP = D + 64;
constexpr float W8_SCALE = 256.f, X8_SCALE = 8.f, H8_SCALE = 4.f, O8_SCALE = 16.f, Y8_SCALE = 16.f;
#ifndef MK_N_LAUNCHES
#define MK_N_LAUNCHES 1
#endif
constexpr int N_PHASES = 14;
#ifndef PROBE_REP
#define PROBE_REP (-1)
#endif

constexpr size_t al256(size_t x) { return (x + 255) & ~(size_t)255; }
constexpr size_t WS_CTL = 0, CTL_ZERO_BYTES = 1u << 20;
constexpr size_t WS_WT_IN  = CTL_ZERO_BYTES;
constexpr size_t WS_WT_OUT = WS_WT_IN  + (size_t)PROJ_N * D * 2;
constexpr size_t WS_WT_XQ  = WS_WT_OUT + (size_t)D * LDP * 2;
constexpr size_t WS_WT_XKV = WS_WT_XQ  + (size_t)D * D * 2;
constexpr size_t WS_WT_XO  = WS_WT_XKV + (size_t)2 * D * D * 2;
constexpr size_t WS_WT_GU  = WS_WT_XO  + (size_t)D * D * 2;
constexpr size_t WS_WT_DN  = WS_WT_GU  + (size_t)NE * 2 * DFF * D * 2;
constexpr size_t WS_XN     = WS_WT_DN  + (size_t)NE * D * DFF * 2;
constexpr size_t WS_PROJ   = WS_XN     + (size_t)T * D * 2;
constexpr size_t WS_GA     = WS_PROJ   + (size_t)T * PROJ_N * 2;
constexpr size_t WS_LF     = WS_GA     + (size_t)T * 16 * 4;
constexpr size_t WS_CF     = WS_LF     + (size_t)T * 8 * 4;
constexpr size_t WS_MEMN   = WS_CF     + (size_t)16 * SEQ * 4;
constexpr size_t WS_KV2    = WS_MEMN   + (size_t)NB * MEM_LEN * D * 2;
constexpr size_t WS_OG     = WS_KV2    + (size_t)NB * MEM_LEN * 2 * D * 2;
constexpr size_t WS_CAT    = WS_OG     + (size_t)T * 1024 * 4;
constexpr size_t WS_H1     = WS_CAT    + (size_t)T * LDP * 2;
constexpr size_t WS_H2     = WS_H1     + (size_t)T * D * 4;
constexpr size_t WS_Q2     = WS_H2     + (size_t)T * D * 4;
constexpr size_t WS_XO     = WS_Q2     + (size_t)T * D * 2;
constexpr size_t WS_TOPE   = WS_XO     + (size_t)T * D * 2;
constexpr size_t WS_TOPG   = WS_TOPE   + (size_t)T * 4 * 4;
constexpr size_t WS_CNT    = WS_TOPG   + (size_t)T * 4 * 4;
constexpr size_t WS_TSLOT  = WS_CNT    + (size_t)256 * 32 * 4;
constexpr size_t WS_RT     = WS_TSLOT  + (size_t)T * 4 * 4;
constexpr size_t WS_UL     = al256(WS_RT + 8192);
constexpr size_t WS_SSP    = WS_UL + 131072;
constexpr size_t WS_XS     = WS_SSP + (size_t)T * 32 * 4;
constexpr size_t WS_HH     = WS_XS     + (size_t)XS_ROWS * D * 2;
constexpr size_t WS_YY     = WS_HH     + (size_t)XS_ROWS * D * 2;
constexpr size_t WS_END    = WS_YY     + (size_t)XS_ROWS * D * 2;
constexpr int CW_TMO = 0, CW_BAR = 4096, CW_KMAX = 2048;

constexpr int RING_OFF = 0, RING_BYTES = 131072;
constexpr int LDSCTL_OFF = 139264, MISC_OFF = LDSCTL_OFF + 320;
constexpr int LDS_BYTES = 147456;


typedef unsigned short bf16;
typedef unsigned v4u __attribute__((ext_vector_type(4)));
typedef unsigned v2u __attribute__((ext_vector_type(2)));
typedef float f32x4 __attribute__((ext_vector_type(4)));
typedef short bf16x8 __attribute__((ext_vector_type(8)));
typedef float f32x16 __attribute__((ext_vector_type(16)));
#define LDS_WAIT() asm volatile("s_waitcnt lgkmcnt(0)" ::: "memory")
#define VM_WAIT() asm volatile("s_waitcnt vmcnt(0)" ::: "memory")
__device__ __forceinline__ unsigned f2bf(float f) { unsigned u = __builtin_bit_cast(unsigned, f); return (u + 0x7fffu + ((u >> 16) & 1u)) >> 16; }
__device__ __forceinline__ unsigned pk2(float lo, float hi) { return f2bf(lo) | (f2bf(hi) << 16); }
__device__ __forceinline__ float bf2f(unsigned short b) { return __builtin_bit_cast(float, (unsigned)b << 16); }
__device__ __forceinline__ float bflo(unsigned w) { return __builtin_bit_cast(float, w << 16); }
__device__ __forceinline__ float bfhi(unsigned w) { return __builtin_bit_cast(float, w & 0xffff0000u); }
struct Args { const float* in[22]; float* out; unsigned char* ws; int ph_lo, ph_hi; };
struct Ctx { LAS unsigned char* lds; unsigned char* ws; int tid, lane, wave, G, bid, gw, ngw; };
enum { I_X = 0, I_MEM, I_NORM_MIX, I_W_IN, I_W_ALPHA, I_B_ALPHA, I_B_FGATE, I_GLA_NORM, I_W_OUT, I_NORM_XATTN, I_NORM_MEM, I_W_XQ, I_W_XKV, I_W_XO,
       I_NORM_MOE, I_W_ROUTER, I_B_ROUTER, I_W_GU, I_B_GU, I_W_DN, I_B_DN, I_NORM_FINAL };

__device__ __forceinline__ float wave_sum(float v) {
#pragma unroll
    for (int o = 1; o < 64; o <<= 1) v += __shfl_xor(v, o);
    return v;
}
__device__ __forceinline__ float wave_max(float v) {
#pragma unroll
    for (int o = 1; o < 64; o <<= 1) v = fmaxf(v, __shfl_xor(v, o));
    return v;
}
__device__ __forceinline__ float log_sigmoid(float x) { return fminf(x, 0.f) - log1pf(__expf(-fabsf(x))); }
__device__ __forceinline__ float silu(float x) { return x / (1.f + __expf(-x)); }

__device__ __forceinline__ void rms_row_to_bf16(const float* xrow, const float* g, bf16* orow, int lane) {
    const f32x4* xr = (const f32x4*)xrow + lane; const f32x4* gr = (const f32x4*)g + lane;
    f32x4 v[8]; float s = 0.f;
#pragma unroll
    for (int j = 0; j < 8; ++j) { v[j] = xr[64 * j]; s += (v[j].x * v[j].x + v[j].y * v[j].y) + (v[j].z * v[j].z + v[j].w * v[j].w); }
    const float rstd = rsqrtf(wave_sum(s) * (1.f / D) + EPS);
    unsigned long long* o8 = (unsigned long long*)orow + lane;
#pragma unroll
    for (int j = 0; j < 8; ++j) { const f32x4 gg = gr[64 * j]; const f32x4 y = v[j] * rstd * gg;
        o8[64 * j] = (unsigned long long)pk2(y.x, y.y) | ((unsigned long long)pk2(y.z, y.w) << 32); }
}

__device__ __forceinline__ void conv_decode(const Args& A, unsigned char* ws, int it, const float*& src, int& ld, unsigned char*& dst) {
    if (it < 65536) { const int e = it >> 11, kb = (it >> 7) & 15, nb = it & 127; ld = 2 * DFF;
        src = A.in[I_W_GU] + ((size_t)e * D + 128 * kb) * (2 * DFF) + 32 * nb; dst = ws + WS_WT_GU + ((size_t)e * 2 * DFF + 32 * nb) * D + 128 * kb; }
    else { it -= 65536; const int e = it >> 10, kb = (it >> 6) & 15, nb = it & 63; ld = D;
        src = A.in[I_W_DN] + ((size_t)e * DFF + 128 * kb) * D + 32 * nb; dst = ws + WS_WT_DN + ((size_t)e * D + 32 * nb) * DFF + 128 * kb; }
}
#define CONV_LOAD(buf, jj) do { conv_decode(A, C.ws, (jj) * C.ngw + C.gw, src_##buf, ld_##buf, dst_##buf); \
        _Pragma("unroll") for (int i_ = 0; i_ < 16; ++i_) buf[i_] = __builtin_nontemporal_load((const f32x4*)(src_##buf + (size_t)(8 * i_ + lr) * ld_##buf + lc)); } while (0)
#define CONV_PROC(buf, jn, MORE) do { unsigned char* dcur_ = dst_##buf; \
        if (MORE) conv_decode(A, C.ws, (jn) * C.ngw + C.gw, src_##buf, ld_##buf, dst_##buf); \
        _Pragma("unroll") for (int i_ = 0; i_ < 16; ++i_) { LAS float* p_ = scr + (8 * i_ + lr) * 33 + lc; const f32x4 v_ = buf[i_] * W8_SCALE; p_[0] = v_.x; p_[1] = v_.y; p_[2] = v_.z; p_[3] = v_.w; \
            if (MORE) buf[i_] = __builtin_nontemporal_load((const f32x4*)(src_##buf + (size_t)(8 * i_ + lr) * ld_##buf + lc)); } \
        LDS_WAIT(); asm volatile("" ::: "memory"); \
        _Pragma("unroll") for (int h_ = 0; h_ < 4; ++h_) { const int n_ = (lane >> 3) + 8 * h_; const LAS float* s_ = scr + (16 * (lane & 7)) * 33 + n_; int w_[4]; \
            _Pragma("unroll") for (int q_ = 0; q_ < 4; ++q_) { int t_ = 0; t_ = __builtin_amdgcn_cvt_pk_fp8_f32(s_[(4 * q_) * 33], s_[(4 * q_ + 1) * 33], t_, false); t_ = __builtin_amdgcn_cvt_pk_fp8_f32(s_[(4 * q_ + 2) * 33], s_[(4 * q_ + 3) * 33], t_, true); w_[q_] = t_; } \
            *(GAS v4u*)(dcur_ + (size_t)n_ * 2048 + 16 * (lane & 7)) = (v4u){(unsigned)w_[0], (unsigned)w_[1], (unsigned)w_[2], (unsigned)w_[3]}; } \
        LDS_WAIT(); asm volatile("" ::: "memory"); } while (0)
__device__ __forceinline__ void conv_items_f8(const Ctx& C, const Args& A, int j_lo, int j_hi) {
    LAS float* scr = (LAS float*)(C.lds + RING_OFF + C.wave * 16896);
    const int lane = lane_id(), lr = lane >> 3, lc = 4 * (lane & 7);
    const float *src_b0, *src_b1; int ld_b0, ld_b1; unsigned char *dst_b0, *dst_b1;
    f32x4 b0[16], b1[16];
    CONV_LOAD(b0, j_lo); CONV_LOAD(b1, j_lo + 1);
#pragma unroll 1
    for (int j = j_lo; j + 2 < j_hi; j += 2) { CONV_PROC(b0, j + 2, 1); CONV_PROC(b1, j + 3, 1); }
    CONV_PROC(b0, 0, 0); CONV_PROC(b1, 0, 0);
}
#undef CONV_LOAD
#undef CONV_PROC
__device__ __forceinline__ void convd_decode(const Args& A, unsigned char* ws, int it, const float*& src, int& ld, unsigned char*& dst, int& f8, int& dld) {
    dld = D;
    if (it < 3072) { const int half = it / 1536, r = it % 1536, kb = r / 96, nb = r % 96; ld = W_IN_LD; f8 = 0;
        src = A.in[I_W_IN] + (size_t)(128 * kb) * W_IN_LD + (half ? 3088 : 0) + 32 * nb; dst = ws + WS_WT_IN + ((size_t)(half * 3072 + 32 * nb) * D + 128 * kb) * 2; }
    else if (it < 4096) { const int r = it - 3072, kb = r >> 6, nb = r & 63; ld = D; f8 = 0; dld = LDP; src = A.in[I_W_OUT] + (size_t)(128 * kb) * D + 32 * nb; dst = ws + WS_WT_OUT + ((size_t)(32 * nb) * LDP + 128 * kb) * 2; }
    else if (it < 6144) { const int r = it - 4096, kb = r >> 7, nb = r & 127; ld = 2 * D; f8 = 0; src = A.in[I_W_XKV] + (size_t)(128 * kb) * (2 * D) + 32 * nb; dst = ws + WS_WT_XKV + ((size_t)(32 * nb) * D + 128 * kb) * 2; }
    else if (it < 7168) { const int r = it - 6144, kb = r >> 6, nb = r & 63; ld = D; f8 = 1; src = A.in[I_W_XQ] + (size_t)(128 * kb) * D + 32 * nb; dst = ws + WS_WT_XQ + (size_t)(32 * nb) * D + 128 * kb; }
    else { const int r = it - 7168, kb = r >> 6, nb = r & 63; ld = D; f8 = 1; src = A.in[I_W_XO] + (size_t)(128 * kb) * D + 32 * nb; dst = ws + WS_WT_XO + (size_t)(32 * nb) * D + 128 * kb; }
}
__device__ __forceinline__ void conv_dense(const Ctx& C, const Args& A, const int it_lo, const int it_hi) {
    LAS float* scr = (LAS float*)(C.lds + RING_OFF + C.wave * 16896);
    const int lane = lane_id(), lr = lane >> 3, lc = 4 * (lane & 7);
    const int NIT = it_hi;
    const float* src; int ld, f8, f8n, dld, dldn; unsigned char *dst, *dnx;
    if (it_lo + C.gw >= NIT) return;
    f32x4 cur[16], nxt[16];
    convd_decode(A, C.ws, it_lo + C.gw, src, ld, dst, f8, dld);
#pragma unroll
    for (int i = 0; i < 16; ++i) cur[i] = __builtin_nontemporal_load((const f32x4*)(src + (size_t)(8 * i + lr) * ld + lc));
#pragma unroll 1
    for (int it = it_lo + C.gw; it < NIT; it += C.ngw) {
        const bool more = it + C.ngw < NIT;
        if (more) { convd_decode(A, C.ws, it + C.ngw, src, ld, dnx, f8n, dldn);
#pragma unroll
            for (int i = 0; i < 16; ++i) nxt[i] = __builtin_nontemporal_load((const f32x4*)(src + (size_t)(8 * i + lr) * ld + lc)); }
        const float sc = f8 ? W8_SCALE : 1.f;
#pragma unroll
        for (int i = 0; i < 16; ++i) { LAS float* p = scr + (8 * i + lr) * 33 + lc; const f32x4 v = cur[i] * sc; p[0] = v.x; p[1] = v.y; p[2] = v.z; p[3] = v.w; }
        LDS_WAIT(); asm volatile("" ::: "memory");
        const int c = lane & 7;
#pragma unroll
        for (int h = 0; h < 4; ++h) { const int n = (lane >> 3) + 8 * h; const LAS float* s = scr + (16 * c) * 33 + n;
            if (f8) { int w[4];
#pragma unroll
                for (int q = 0; q < 4; ++q) { int t = 0; t = __builtin_amdgcn_cvt_pk_fp8_f32(s[(4 * q) * 33], s[(4 * q + 1) * 33], t, false); t = __builtin_amdgcn_cvt_pk_fp8_f32(s[(4 * q + 2) * 33], s[(4 * q + 3) * 33], t, true); w[q] = t; }
                *(GAS v4u*)(dst + (size_t)n * dld + 16 * c) = (v4u){(unsigned)w[0], (unsigned)w[1], (unsigned)w[2], (unsigned)w[3]}; }
            else { unsigned w[8];
#pragma unroll
                for (int q = 0; q < 8; ++q) w[q] = pk2(s[(2 * q) * 33], s[(2 * q + 1) * 33]);
                *(GAS v4u*)(dst + ((size_t)n * dld + 16 * c) * 2) = (v4u){w[0], w[1], w[2], w[3]}; *(GAS v4u*)(dst + ((size_t)n * dld + 16 * c) * 2 + 16) = (v4u){w[4], w[5], w[6], w[7]}; } }
        LDS_WAIT(); asm volatile("" ::: "memory");
        if (more) {
#pragma unroll
            for (int i = 0; i < 16; ++i) cur[i] = nxt[i];
            dst = dnx; f8 = f8n; dld = dldn; }
    }
}
template <int MODE> __device__ __forceinline__ void rows32_proj(const Ctx& C, int blk, const float* SRC, const float* nm, const float* W, int ldw, int wofs, void* OUT) {
    LAS float* RS = (LAS float*)(C.lds + 256); LAS float* PART = (LAS float*)(C.lds + 1024); LAS float* LG = (LAS float*)(C.lds + 1024 + 32768);
    const int lane = C.lane, tl = lane & 31, kk = lane >> 5;
    { f32x4 v[4][8];
#pragma unroll
      for (int q = 0; q < 4; ++q) { const f32x4* xr = (const f32x4*)(SRC + (size_t)(blk * 32 + C.wave * 4 + q) * D) + lane;
#pragma unroll
          for (int j = 0; j < 8; ++j) v[q][j] = xr[64 * j]; }
      const f32x4* gr = (const f32x4*)nm + lane;
#pragma unroll
      for (int q = 0; q < 4; ++q) { const int t = blk * 32 + C.wave * 4 + q; float s = 0.f;
#pragma unroll
        for (int j = 0; j < 8; ++j) s += (v[q][j].x * v[q][j].x + v[q][j].y * v[q][j].y) + (v[q][j].z * v[q][j].z + v[q][j].w * v[q][j].w);
        const float rstd = rsqrtf(wave_sum(s) * (1.f / D) + EPS);
        if constexpr (MODE == 0) { unsigned long long* o8 = (unsigned long long*)((bf16*)OUT + (size_t)t * D) + lane;
#pragma unroll
            for (int j = 0; j < 8; ++j) { const f32x4 gg = gr[64 * j]; const f32x4 y = v[q][j] * rstd * gg;
                o8[64 * j] = (unsigned long long)pk2(y.x, y.y) | ((unsigned long long)pk2(y.z, y.w) << 32); } }
        else { int* o4 = (int*)((unsigned char*)OUT + (size_t)t * D) + lane;
#pragma unroll
            for (int j = 0; j < 8; ++j) { const f32x4 gg = gr[64 * j]; const f32x4 y = v[q][j] * (rstd * X8_SCALE) * gg;
                int w = 0; w = __builtin_amdgcn_cvt_pk_fp8_f32(y.x, y.y, w, false); w = __builtin_amdgcn_cvt_pk_fp8_f32(y.z, y.w, w, true); o4[64 * j] = w; } }
        if (lane == 0) RS[C.wave * 4 + q] = rstd; } }
    f32x16 acc;
#pragma unroll
    for (int e = 0; e < 16; ++e) acc[e] = 0.f;
    const float* xrow = SRC + (size_t)(blk * 32 + tl) * D + 256 * C.wave + 4 * kk;
    const float* grow = nm + 256 * C.wave + 4 * kk; const float* wcol = W + (size_t)(256 * C.wave + 4 * kk) * ldw + wofs;
#pragma unroll 8
    for (int m = 0; m < 32; ++m) { const f32x4 x4 = *(const f32x4*)(xrow + 8 * m), g4 = *(const f32x4*)(grow + 8 * m);
        const float w0 = wcol[(size_t)(8 * m) * ldw], w1 = wcol[(size_t)(8 * m + 1) * ldw], w2 = wcol[(size_t)(8 * m + 2) * ldw], w3 = wcol[(size_t)(8 * m + 3) * ldw];
        acc = __builtin_amdgcn_mfma_f32_32x32x2f32(x4.x * g4.x, w0, acc, 0, 0, 0); acc = __builtin_amdgcn_mfma_f32_32x32x2f32(x4.y * g4.y, w1, acc, 0, 0, 0);
        acc = __builtin_amdgcn_mfma_f32_32x32x2f32(x4.z * g4.z, w2, acc, 0, 0, 0); acc = __builtin_amdgcn_mfma_f32_32x32x2f32(x4.w * g4.w, w3, acc, 0, 0, 0); }
#pragma unroll
    for (int e = 0; e < 16; ++e) PART[(C.wave * 16 + e) * 64 + lane] = acc[e];
    __syncthreads();
#pragma unroll
    for (int rep = 0; rep < 2; ++rep) { const int idx = C.tid + 512 * rep, reg = idx >> 6, ln = idx & 63; float s = 0.f;
#pragma unroll
        for (int w = 0; w < 8; ++w) s += PART[(w * 16 + reg) * 64 + ln];
        const int t = (reg & 3) + 8 * (reg >> 2) + 4 * (ln >> 5), e = ln & 31;
        LG[t * 33 + e] = s * RS[t]; }
    __syncthreads();
}
__device__ __forceinline__ void p0_prologue(const Ctx& C, const Args& A) {
    unsigned char* ws = C.ws;
    conv_dense(C, A, 0, 3072);
    { float* GA = (float*)(ws + WS_GA); float* LF = (float*)(ws + WS_LF); const LAS float* LG = (const LAS float*)(C.lds + 1024 + 32768);
      const int tl = C.lane & 31; const int wofs = tl < 16 ? WIN_GA + tl : (tl < 24 ? WIN_FF + tl - 16 : WIN_GA);
      for (int blk = C.bid; blk < T / 32; blk += C.G) {
          __syncthreads();
          rows32_proj<0>(C, blk, A.in[I_X], A.in[I_NORM_MIX], A.in[I_W_IN], W_IN_LD, wofs, ws + WS_XN);
          { const int t = C.tid >> 4, j = C.tid & 15; GA[(size_t)(blk * 32 + t) * 16 + j] = LG[t * 33 + j]; }
          if (C.tid < 256) { const int t = C.tid >> 3, h = C.tid & 7; LF[(size_t)(blk * 32 + t) * 8 + h] = log_sigmoid(LG[t * 33 + 16 + h] + A.in[I_B_FGATE][h]); }
      } }
    for (int m = C.gw; m < NB * MEM_LEN; m += C.ngw) rms_row_to_bf16(A.in[I_MEM] + (size_t)m * D, A.in[I_NORM_MEM], (bf16*)(ws + WS_MEMN) + (size_t)m * D, C.lane);
}

__device__ __forceinline__ void cumsum_cf(const Ctx& C) {
    if (C.gw >= 16) return;
    const int b = C.gw >> 3, h = C.gw & 7; const float* LF = (const float*)(C.ws + WS_LF); float* CF = (float*)(C.ws + WS_CF) + (size_t)C.gw * SEQ;
    const float* src = LF + ((size_t)b * SEQ + C.lane * 64) * 8 + h;
    float v[64]; float loc = 0.f;
#pragma unroll
    for (int i = 0; i < 64; ++i) v[i] = src[i * 8];
#pragma unroll
    for (int i = 0; i < 64; ++i) loc += v[i];
    float inc = loc;
#pragma unroll
    for (int o = 1; o < 64; o <<= 1) { const float t = __shfl_up(inc, o); if (C.lane >= o) inc += t; }
    float run = inc - loc;
#pragma unroll
    for (int i = 0; i < 64; ++i) { run += v[i]; CF[C.lane * 64 + i] = -run * 1.4426950408889634f; }
}
typedef short s16x4 __attribute__((ext_vector_type(4)));
typedef short v4i16_t __attribute__((ext_vector_type(4)));
typedef float f32x2_t __attribute__((ext_vector_type(2)));
typedef __bf16 bf16x2_t __attribute__((ext_vector_type(2)));
#define MFMA32(a, b, c) __builtin_amdgcn_mfma_f32_32x32x16_bf16((a), (b), (c), 0, 0, 0)
__device__ __forceinline__ s16x4 tr_read(const LAS unsigned char* p) { return __builtin_bit_cast(s16x4, __builtin_amdgcn_ds_read_tr16_b64_v4i16((LAS v4i16_t*)p)); }
__device__ __forceinline__ unsigned cvtpk(float lo, float hi) { f32x2_t v = {lo, hi}; bf16x2_t b = __builtin_convertvector(v, bf16x2_t); return __builtin_bit_cast(unsigned, b); }
__device__ __forceinline__ bf16x8 pack8(const f32x16& x, int s) {
    v4u p; p.x = cvtpk(x[8 * s], x[8 * s + 1]); p.y = cvtpk(x[8 * s + 2], x[8 * s + 3]); p.z = cvtpk(x[8 * s + 4], x[8 * s + 5]); p.w = cvtpk(x[8 * s + 6], x[8 * s + 7]);
    return __builtin_bit_cast(bf16x8, p);
}
__device__ __forceinline__ int fox_vaddr(int k, int c) { return ((k >> 3) * 4 + (c >> 5)) * 512 + (k & 7) * 64 + (c & 31) * 2; }

__device__ __forceinline__ void fox_phase(const Ctx& C) {
    constexpr int FB = 66048;
    LAS float* XCH = (LAS float*)C.lds; volatile LAS int* STOPF = (volatile LAS int*)(C.lds + 2 * FB);
    const bf16* PROJ = (const bf16*)(C.ws + WS_PROJ); bf16* CAT = (bf16*)(C.ws + WS_CAT); const float* CF = (const float*)(C.ws + WS_CF);
    const int lane = C.lane, r = lane & 31, hh = lane >> 5, qi = C.wave & 3, kh = C.wave >> 2;
    const int i16 = lane & 15, blk = (lane >> 4) & 1;
    constexpr float LOG2E = 1.4426950408889634f, C1 = 0.08838834764831845f * LOG2E;
    const unsigned ldsb = (unsigned)(unsigned long long)C.lds;
    const int vlane = (4 * hh + (i16 >> 2)) * 64 + 32 * blk + 8 * (i16 & 3);
    for (int unit = C.bid; unit < 256; unit += C.G) {
        const int bh = unit >> 4, x = unit & 15, b = bh >> 3, h = bh & 7;
        const float kmax2 = __uint_as_float(((const unsigned*)(C.ws + WS_CTL))[CW_KMAX + bh]);
#pragma unroll 1
        for (int pass = 0; pass < 2; ++pass) {
            const int X = pass ? 31 - x : x, q0 = 128 * X;
            const size_t qrow0 = (size_t)b * SEQ + q0 + 32 * qi;
            const char* qbase = (const char*)(PROJ + qrow0 * PROJ_N + PJ_FQ + h * 128);
            const unsigned qlo = (unsigned)((r * PROJ_N + 8 * hh) * 2);
            bf16x8 qf[8];
#pragma unroll
            for (int ks = 0; ks < 8; ++ks) qf[ks] = *(const bf16x8*)(qbase + qlo + 32 * ks);
            float ubq;
            { float qn = 0.f;
#pragma unroll
              for (int ks = 0; ks < 8; ++ks)
#pragma unroll
                  for (int j = 0; j < 8; ++j) { const float v = bf2f((unsigned short)qf[ks][j]); qn += v * v; }
              qn += __shfl_xor(qn, 32);
#pragma unroll
              for (int o_ = 1; o_ < 32; o_ <<= 1) qn = fmaxf(qn, __shfl_xor(qn, o_));
              ubq = sqrtf(qn * kmax2) * C1 * 1.01f + 1.f; }
            f32x16 o[4];
#pragma unroll
            for (int d = 0; d < 4; ++d)
#pragma unroll
                for (int e = 0; e < 16; ++e) o[d][e] = 0.f;
            float m = -1e30f, l = 0.f;
            const bf16* kvbase = PROJ + (size_t)b * SEQ * PROJ_N + PJ_FK + h * 128;
            const float* cfb = CF + (size_t)bh * SEQ;
            const int tl = C.wave >> 2, pc0 = (C.wave & 3) * 4;
            unsigned koff[4], voff[4];
#pragma unroll
            for (int i = 0; i < 4; ++i) { const int pc = pc0 + i, row = 4 * pc + (lane >> 4), sch = (lane & 15) ^ (row & 15);
                koff[i] = (unsigned)(((tl * 64 + row) * PROJ_N + sch * 8) * 2);
                const int sidx = 2 * pc + (lane >> 5), key = 8 * (sidx >> 2) + ((lane & 31) >> 2), col = 32 * (sidx & 3) + 8 * (lane & 3);
                voff[i] = (unsigned)(((tl * 64 + key) * PROJ_N + (PJ_FV - PJ_FK) + col) * 2); }
#define FOX_STAGE(stp, bufi) do { const char* gb_ = (const char*)(kvbase + (size_t)(128 * (stp)) * PROJ_N); const unsigned lb_ = ldsb + (bufi) * FB + tl * 16384 + pc0 * 1024; \
                _Pragma("unroll") for (int i_ = 0; i_ < 4; ++i_) { glds16s(gb_, koff[i_], lb_ + i_ * 1024); glds16s(gb_, voff[i_], lb_ + 32768 + i_ * 1024); } \
                if (C.wave < 2) glds4s(cfb + 128 * (stp) + C.wave * 64, (unsigned)(lane * 4), ldsb + (bufi) * FB + 65536 + C.wave * 256); } while (0)
            __syncthreads();
            if (C.tid < 16) STOPF[C.tid] = 0;
            FOX_STAGE(X, 0);
            int st = X, bufi = 0;
#pragma unroll 1
            for (;;) {
                asm volatile("s_waitcnt vmcnt(0)" ::: "memory");
                __syncthreads();
                volatile LAS int* sfr = STOPF + (((st + 1) & 1) << 3);
                const bool allstop = (sfr[0] & sfr[1] & sfr[2] & sfr[3] & sfr[4] & sfr[5] & sfr[6] & sfr[7]) != 0;
                const bool stage_next = (st > 0) && !allstop;
                if (stage_next) FOX_STAGE(st - 1, bufi ^ 1);
                LAS unsigned char* Ks = C.lds + bufi * FB; LAS unsigned char* Vs = Ks + 32768; const LAS float* NBs = (const LAS float*)(Ks + 65536);
                f32x16 s0, s1;
#pragma unroll
                for (int e = 0; e < 16; ++e) { s0[e] = 0.f; s1[e] = 0.f; }
                const LAS unsigned char* kt = Ks + kh * 16384;
                const LAS unsigned char* kr0 = kt + r * 256; const int kx = (r & 15) << 4;
                bf16x8 a0 = *(const LAS bf16x8*)(kr0 + ((hh * 16) ^ kx)), a1 = *(const LAS bf16x8*)(kr0 + 8192 + ((hh * 16) ^ kx));
#pragma unroll
                for (int ks = 0; ks < 8; ++ks) {
                    bf16x8 n0 = a0, n1 = a1;
                    if (ks < 7) { n0 = *(const LAS bf16x8*)(kr0 + (((ks + 1) * 32 + hh * 16) ^ kx)); n1 = *(const LAS bf16x8*)(kr0 + 8192 + (((ks + 1) * 32 + hh * 16) ^ kx)); }
                    s0 = MFMA32(a0, qf[ks], s0); s1 = MFMA32(a1, qf[ks], s1);
                    __builtin_amdgcn_sched_barrier(0);
                    a0 = n0; a1 = n1;
                }
                const int keyb = 128 * st + 64 * kh;
                const LAS float* nb = NBs + 64 * kh + 4 * hh;
#pragma unroll
                for (int g = 0; g < 4; ++g) { const f32x4 b0 = *(const LAS f32x4*)(nb + 8 * g), b1 = *(const LAS f32x4*)(nb + 32 + 8 * g);
#pragma unroll
                    for (int j = 0; j < 4; ++j) { s0[4 * g + j] = s0[4 * g + j] * C1 + b0[j]; s1[4 * g + j] = s1[4 * g + j] * C1 + b1[j]; } }
                if (st == X) {
                    const int qabs = q0 + 32 * qi + r; const float NEG = -__builtin_inff();
#pragma unroll
                    for (int e = 0; e < 16; ++e) { const int key = keyb + (e & 3) + 8 * (e >> 2) + 4 * hh;
                        if (key > qabs) s0[e] = NEG; if (key + 32 > qabs) s1[e] = NEG; }
                }
                float mx = s0[0];
#pragma unroll
                for (int e = 1; e < 16; ++e) mx = fmaxf(mx, s0[e]);
#pragma unroll
                for (int e = 0; e < 16; ++e) mx = fmaxf(mx, s1[e]);
                mx = fmaxf(mx, __shfl_xor(mx, 32));
                const float mn = fmaxf(m, mx), alpha = __builtin_amdgcn_exp2f(m - mn); m = mn;
                float ps = 0.f;
#pragma unroll
                for (int e = 0; e < 16; ++e) { s0[e] = __builtin_amdgcn_exp2f(s0[e] - mn); s1[e] = __builtin_amdgcn_exp2f(s1[e] - mn); ps += s0[e] + s1[e]; }
                l = l * alpha + ps;
#pragma unroll
                for (int d = 0; d < 4; ++d)
#pragma unroll
                    for (int e = 0; e < 16; ++e) o[d][e] *= alpha;
                __builtin_amdgcn_sched_barrier(0);
                bf16x8 pb[2][2]; pb[0][0] = pack8(s0, 0); pb[0][1] = pack8(s0, 1); pb[1][0] = pack8(s1, 0); pb[1][1] = pack8(s1, 1);
                const LAS unsigned char* vt = Vs + kh * 16384 + vlane;
#define FOX_VLD(dst, grp) do { _Pragma("unroll") for (int d_ = 0; d_ < 4; ++d_) { \
                    const s16x4 lo_ = tr_read(vt + ((2 * (grp)) * 4 + d_) * 512), hi_ = tr_read(vt + ((2 * (grp) + 1) * 4 + d_) * 512); \
                    dst[d_] = __builtin_shufflevector(lo_, hi_, 0, 1, 2, 3, 4, 5, 6, 7); } } while (0)
                bf16x8 va[4], vn[4];
                FOX_VLD(va, 0);
#pragma unroll
                for (int grp = 0; grp < 4; ++grp) {
                    if (grp < 3) FOX_VLD(vn, grp + 1);
#pragma unroll
                    for (int d = 0; d < 4; ++d) o[d] = MFMA32(va[d], pb[grp >> 1][grp & 1], o[d]);
                    __builtin_amdgcn_sched_barrier(0);
                    if (grp < 3) {
#pragma unroll
                        for (int d = 0; d < 4; ++d) va[d] = vn[d]; }
                }
                { int stopw = 0;
                  if (st >= 2) { float mmin = m;
#pragma unroll
                      for (int o_ = 1; o_ < 32; o_ <<= 1) mmin = fminf(mmin, __shfl_xor(mmin, o_));
                      stopw = (cfb[128 * (st - 2) + 127] + ubq < mmin - 40.f) ? 1 : 0; }
                  if (lane == 0) STOPF[((st & 1) << 3) + C.wave] = stopw; }
                if (!stage_next) break;
                st -= 1; bufi ^= 1;
            }
            l += __shfl_xor(l, 32);
            __syncthreads();
            if (kh == 1) {
#pragma unroll
                for (int d = 0; d < 4; ++d)
#pragma unroll
                    for (int e = 0; e < 16; ++e) XCH[(d * 16 + e) * 256 + qi * 64 + lane] = o[d][e];
                XCH[64 * 256 + qi * 64 + lane] = m; XCH[65 * 256 + qi * 64 + lane] = l;
            }
            __syncthreads();
            if (kh == 0) {
                const float m1 = XCH[64 * 256 + qi * 64 + lane], l1 = XCH[65 * 256 + qi * 64 + lane];
                const float mm = fmaxf(m, m1), a0 = __builtin_amdgcn_exp2f(m - mm), a1 = __builtin_amdgcn_exp2f(m1 - mm);
                const float inv = 1.f / (l * a0 + l1 * a1), w0 = a0 * inv, w1 = a1 * inv;
                LAS unsigned char* ot = C.lds + 67584 + qi * 8704;
#pragma unroll
                for (int d = 0; d < 4; ++d)
#pragma unroll
                    for (int g = 0; g < 4; ++g) { float y[4];
#pragma unroll
                        for (int j = 0; j < 4; ++j) y[j] = o[d][4 * g + j] * w0 + XCH[(d * 16 + 4 * g + j) * 256 + qi * 64 + lane] * w1;
                        v2u w; w.x = cvtpk(y[0], y[1]); w.y = cvtpk(y[2], y[3]);
                        *(LAS v2u*)(ot + r * 272 + (32 * d + 8 * g + 4 * hh) * 2) = w; }
                LDS_WAIT(); asm volatile("" ::: "memory");
                char* obase = (char*)(CAT + qrow0 * LDP + 1024 + h * 128);
#pragma unroll
                for (int i = 0; i < 8; ++i) { const int row = 4 * i + (lane >> 4), ch = lane & 15;
                    *(v4u*)(obase + (unsigned)(row * LDP * 2 + ch * 16)) = *(const LAS v4u*)(ot + row * 272 + ch * 16); }
            }
        }
    }
}
__device__ __forceinline__ void xattn_phase(const Ctx& C) {
    const bf16* Q2 = (const bf16*)(C.ws + WS_Q2); const bf16* KV2 = (const bf16*)(C.ws + WS_KV2); unsigned char* XO = (unsigned char*)(C.ws + WS_XO);
    const int lane = C.lane, r = lane & 31, hh = lane >> 5, qi = C.wave & 3, kh = C.wave >> 2;
    const int i16 = lane & 15, blk = (lane >> 4) & 1;
    const unsigned ldsb = (unsigned)(unsigned long long)C.lds;
    const int vlane = (4 * hh + (i16 >> 2)) * 64 + 32 * blk + 8 * (i16 & 3);
    LAS float* EXM = (LAS float*)(C.lds + 65536); LAS float* EXL = EXM + 512; LAS unsigned char* PX = C.lds + 65536 + 4096;
    for (int unit = C.bid; unit < 256; unit += C.G) {
        const int b = unit >> 7, hd = (unit >> 5) & 3, qb = unit & 31;
        const size_t qrow0 = (size_t)b * SEQ + qb * 128 + 32 * qi;
        const char* qbase = (const char*)(Q2 + qrow0 * D + hd * XDH); const unsigned qlo = (unsigned)((r * D + 8 * hh) * 2);
        const char* kvb = (const char*)(KV2 + (size_t)b * MEM_LEN * 2 * D + hd * XDH);
        unsigned koff[8], voff[8];
#pragma unroll
        for (int i = 0; i < 8; ++i) { const int pc = C.wave * 8 + i;
            { const int half = pc >> 5, row = 4 * (pc & 31) + (lane >> 4), sch = (lane & 15) ^ (row & 15); koff[i] = (unsigned)(((128 * half + row) * 2 * D + sch * 8) * 2); }
            { const int sidx = 2 * pc + (lane >> 5), key = 8 * (sidx >> 2) + ((lane & 31) >> 2), col = 32 * (sidx & 3) + 8 * (lane & 3); voff[i] = (unsigned)((key * 2 * D + D + col) * 2); } }
#define XA_STAGE_K(c, bufi) do { _Pragma("unroll") for (int i_ = 0; i_ < 8; ++i_) glds16s(kvb + (c) * 256, koff[i_], ldsb + (bufi) * 65536 + (C.wave * 8 + i_) * 1024); } while (0)
#define XA_STAGE_V(c, bufi) do { _Pragma("unroll") for (int i_ = 0; i_ < 8; ++i_) glds16s(kvb + (c) * 256, voff[i_], ldsb + (bufi) * 65536 + (C.wave * 8 + i_) * 1024); } while (0)
        f32x16 sT[4];
#pragma unroll
        for (int kb = 0; kb < 4; ++kb)
#pragma unroll
            for (int e = 0; e < 16; ++e) sT[kb][e] = 0.f;
        bf16x8 qf[8], qn[8];
#pragma unroll
        for (int ks = 0; ks < 8; ++ks) qf[ks] = *(const bf16x8*)(qbase + qlo + 32 * ks);
        __syncthreads();
        XA_STAGE_K(0, 0);
#pragma unroll 1
        for (int c = 0; c < 4; ++c) {
            asm volatile("s_waitcnt vmcnt(0)" ::: "memory");
            __syncthreads();
            if (c < 3) {
#pragma unroll
                for (int ks = 0; ks < 8; ++ks) qn[ks] = *(const bf16x8*)(qbase + qlo + (c + 1) * 256 + 32 * ks);
                XA_STAGE_K(c + 1, (c + 1) & 1);
            } else { XA_STAGE_V(0, 0); }
            const LAS unsigned char* kr0 = C.lds + (c & 1) * 65536 + kh * 32768 + r * 256; const int kx = (r & 15) << 4;
            bf16x8 a[4], an[4];
#pragma unroll
            for (int kb = 0; kb < 4; ++kb) a[kb] = *(const LAS bf16x8*)(kr0 + kb * 8192 + ((hh * 16) ^ kx));
#pragma unroll
            for (int ks = 0; ks < 8; ++ks) {
                if (ks < 7) {
#pragma unroll
                    for (int kb = 0; kb < 4; ++kb) an[kb] = *(const LAS bf16x8*)(kr0 + kb * 8192 + (((ks + 1) * 32 + hh * 16) ^ kx)); }
#pragma unroll
                for (int kb = 0; kb < 4; ++kb) sT[kb] = MFMA32(a[kb], qf[ks], sT[kb]);
                __builtin_amdgcn_sched_barrier(0);
                if (ks < 7) {
#pragma unroll
                    for (int kb = 0; kb < 4; ++kb) a[kb] = an[kb]; }
            }
            if (c < 3) {
#pragma unroll
                for (int ks = 0; ks < 8; ++ks) qf[ks] = qn[ks]; }
        }
        float mloc = sT[0][0];
#pragma unroll
        for (int kb = 0; kb < 4; ++kb)
#pragma unroll
            for (int e = 0; e < 16; ++e) mloc = fmaxf(mloc, sT[kb][e]);
        mloc = fmaxf(mloc, __shfl_xor(mloc, 32));
        __syncthreads();
        EXM[C.wave * 64 + lane] = mloc;
        __syncthreads();
        const float mm = fmaxf(mloc, EXM[(C.wave ^ 4) * 64 + lane]);
        float lloc = 0.f;
#pragma unroll
        for (int kb = 0; kb < 4; ++kb)
#pragma unroll
            for (int e = 0; e < 16; ++e) { sT[kb][e] = __builtin_amdgcn_exp2f(sT[kb][e] - mm); lloc += sT[kb][e]; }
        lloc += __shfl_xor(lloc, 32);
        bf16x8 pb[8];
#pragma unroll
        for (int f = 0; f < 8; ++f) pb[f] = pack8(sT[f >> 1], f & 1);
#pragma unroll
        for (int f = 0; f < 8; ++f) *(LAS bf16x8*)(PX + ((C.wave * 8 + f) * 64 + lane) * 16) = pb[f];
        EXL[C.wave * 64 + lane] = lloc;
        __syncthreads();
        bf16x8 pq[8];
#pragma unroll
        for (int f = 0; f < 8; ++f) pq[f] = *(const LAS bf16x8*)(PX + (((C.wave ^ 4) * 8 + f) * 64 + lane) * 16);
        const float inv = 1.f / (lloc + EXL[(C.wave ^ 4) * 64 + lane]);
        bf16x8 pall[16];
#pragma unroll
        for (int f = 0; f < 8; ++f) { pall[f] = kh ? pq[f] : pb[f]; pall[8 + f] = kh ? pb[f] : pq[f]; }
        char* obase = (char*)(XO + qrow0 * D + hd * XDH); const unsigned olo = (unsigned)(r * D + 4 * hh); const float osc = inv * O8_SCALE;
#pragma unroll 1
        for (int cc = 0; cc < 4; ++cc) {
            asm volatile("s_waitcnt vmcnt(0)" ::: "memory");
            __syncthreads();
            if (cc < 3) XA_STAGE_V(cc + 1, (cc + 1) & 1);
            const LAS unsigned char* vt = C.lds + (cc & 1) * 65536 + vlane + (2 * kh) * 512;
            f32x16 o[2];
#pragma unroll
            for (int j = 0; j < 2; ++j)
#pragma unroll
                for (int e = 0; e < 16; ++e) o[j][e] = 0.f;
#define XA_VLD(dst, kg) do { _Pragma("unroll") for (int j_ = 0; j_ < 2; ++j_) { \
                const s16x4 lo_ = tr_read(vt + ((2 * (kg)) * 4 + j_) * 512), hi_ = tr_read(vt + ((2 * (kg) + 1) * 4 + j_) * 512); \
                dst[j_] = __builtin_shufflevector(lo_, hi_, 0, 1, 2, 3, 4, 5, 6, 7); } } while (0)
            bf16x8 va[2], vn[2];
            XA_VLD(va, 0);
#pragma unroll
            for (int kg = 0; kg < 16; ++kg) {
                if (kg < 15) XA_VLD(vn, kg + 1);
                o[0] = MFMA32(va[0], pall[kg], o[0]); o[1] = MFMA32(va[1], pall[kg], o[1]);
                __builtin_amdgcn_sched_barrier(0);
                if (kg < 15) { va[0] = vn[0]; va[1] = vn[1]; }
            }
#pragma unroll
            for (int j = 0; j < 2; ++j)
#pragma unroll
                for (int g = 0; g < 4; ++g) { int w = 0; w = __builtin_amdgcn_cvt_pk_fp8_f32(o[j][4 * g] * osc, o[j][4 * g + 1] * osc, w, false); w = __builtin_amdgcn_cvt_pk_fp8_f32(o[j][4 * g + 2] * osc, o[j][4 * g + 3] * osc, w, true);
                    *(int*)(obase + olo + (128 * cc + 32 * (2 * kh + j) + 8 * g)) = w; }
        }
    }
}
constexpr size_t WS_KVT = WS_HH;
constexpr size_t WS_SB  = WS_HH + (size_t)512 * 256 * 128 * 2;
constexpr size_t WS_DEC = WS_SB + (size_t)512 * 256 * 128 * 2;
constexpr size_t WS_QIN = WS_DEC + (size_t)512 * 128 * 4;
constexpr size_t WS_KIN = WS_QIN + (size_t)T * 512 * 2;
static_assert(WS_KIN + (size_t)T * 512 * 2 <= WS_YY, "GLA scratch inside HH");
constexpr int GL_V = 0, GL_QI = 32768, GL_KI = GL_QI + 16384, GL_PM = GL_KI + 16384, GL_GA = GL_PM + 64 * 144, GL_SEG = GL_GA + 4096, GL_KET = GL_QI, GL_OT = 0;

__device__ __forceinline__ void gla_G(const Ctx& C, const Args& A, int h, size_t tok0, float (&g)[16], float& glast) {
    LAS float* GAs = (LAS float*)(C.lds + GL_GA); LAS float* SEG = (LAS float*)(C.lds + GL_SEG);
    const float* GA = (const float*)(C.ws + WS_GA);
    const int dk = C.tid & 127, tq = C.tid >> 7;
    { const float2 v = *(const float2*)(GA + tok0 * 16 + 2 * C.tid); GAs[2 * C.tid] = v.x; GAs[2 * C.tid + 1] = v.y; }
    float w[16];
#pragma unroll
    for (int j = 0; j < 16; ++j) w[j] = A.in[I_W_ALPHA][j * 512 + h * 128 + dk];
    const float bias = A.in[I_B_ALPHA][h * 128 + dk];
    __syncthreads();
    float run = 0.f;
#pragma unroll
    for (int i = 0; i < 16; ++i) { const LAS float* ga = GAs + (16 * tq + i) * 16; float z = bias;
#pragma unroll
        for (int j = 0; j < 16; ++j) z += ga[j] * w[j];
        run += (fminf(z, 0.f) - __logf(1.f + __expf(-fabsf(z)))) * (1.f / 16.f); g[i] = run; }
    SEG[tq * 128 + dk] = run;
    __syncthreads();
    float pre = 0.f, tot = 0.f;
#pragma unroll
    for (int q = 0; q < 4; ++q) { const float s = SEG[q * 128 + dk]; tot += s; pre += (q < tq) ? s : 0.f; }
#pragma unroll
    for (int i = 0; i < 16; ++i) g[i] += pre;
    glast = tot;
}
__device__ __forceinline__ void gla_stage_v(const Ctx& C, const bf16* vsrc  ) {
    const unsigned ldsb = (unsigned)(unsigned long long)C.lds;
#pragma unroll
    for (int i = 0; i < 4; ++i) { const int pc = C.wave * 4 + i, sidx = 2 * pc + (C.lane >> 5), t = 8 * (sidx >> 3) + ((C.lane & 31) >> 2), col = 32 * (sidx & 7) + 8 * (C.lane & 3);
        glds16s(vsrc, (unsigned)((t * PROJ_N + col) * 2), ldsb + GL_V + pc * 1024); }
}
__device__ __forceinline__ void gla_a_phase(const Ctx& C, const Args& A) {
    const bf16* PROJ = (const bf16*)(C.ws + WS_PROJ); bf16* KVT = (bf16*)(C.ws + WS_KVT); float* DEC = (float*)(C.ws + WS_DEC);
    const int lane = C.lane, r = lane & 31, hh = lane >> 5, i16 = lane & 15, blk = (lane >> 4) & 1;
    const int dk = C.tid & 127, tq = C.tid >> 7;
    LAS unsigned char* KET = C.lds + GL_KET;
    for (int unit = C.bid; unit < 512; unit += C.G) {
        const int bh = unit >> 6, n = unit & 63, b = bh >> 2, h = bh & 3; const size_t tok0 = (size_t)b * SEQ + 64 * n;
        __syncthreads();
        gla_stage_v(C, PROJ + tok0 * PROJ_N + PJ_GV + h * 256);
        float qv[16], kv[16];
#pragma unroll
        for (int i = 0; i < 16; ++i) { const size_t t0 = tok0 + 16 * tq + i; kv[i] = bf2f(PROJ[t0 * PROJ_N + PJ_GK + h * 128 + dk]); qv[i] = bf2f(PROJ[t0 * PROJ_N + PJ_GQ + h * 128 + dk]); }
        float g[16], glast; gla_G(C, A, h, tok0, g, glast);
        { unsigned pk[8]; bf16* QIN = (bf16*)(C.ws + WS_QIN); bf16* KIN = (bf16*)(C.ws + WS_KIN);
#pragma unroll
          for (int i = 0; i < 16; i += 2) { const size_t t0 = tok0 + 16 * tq + i;
              pk[i >> 1] = cvtpk(kv[i] * __expf(glast - g[i]), kv[i + 1] * __expf(glast - g[i + 1]));
              const float e0 = __expf(g[i]), e1 = __expf(g[i + 1]);
              QIN[t0 * 512 + h * 128 + dk] = (bf16)f2bf(qv[i] * e0); QIN[(t0 + 1) * 512 + h * 128 + dk] = (bf16)f2bf(qv[i + 1] * e1);
              KIN[t0 * 512 + h * 128 + dk] = (bf16)f2bf(kv[i] * __builtin_amdgcn_rcpf(e0)); KIN[(t0 + 1) * 512 + h * 128 + dk] = (bf16)f2bf(kv[i + 1] * __builtin_amdgcn_rcpf(e1)); }
          *(LAS v4u*)(KET + dk * 144 + tq * 32) = (v4u){pk[0], pk[1], pk[2], pk[3]}; *(LAS v4u*)(KET + dk * 144 + tq * 32 + 16) = (v4u){pk[4], pk[5], pk[6], pk[7]}; }
        if (tq == 0) DEC[(size_t)unit * 128 + dk] = __expf(glast);
        asm volatile("s_waitcnt vmcnt(0)" ::: "memory");
        __syncthreads();
        f32x16 acc[4];
#pragma unroll
        for (int q = 0; q < 4; ++q)
#pragma unroll
            for (int e = 0; e < 16; ++e) acc[q][e] = 0.f;
        const LAS unsigned char* vt = C.lds + GL_V + C.wave * 512 + (i16 >> 2) * 64 + 32 * blk + 8 * (i16 & 3);
#pragma unroll
        for (int ks = 0; ks < 4; ++ks) {
            const s16x4 lo = tr_read(vt + ((2 * ks + hh) * 8) * 512), hi = tr_read(vt + ((2 * ks + hh) * 8) * 512 + 256);
            const bf16x8 vb = __builtin_shufflevector(lo, hi, 0, 1, 2, 3, 4, 5, 6, 7);
#pragma unroll
            for (int q = 0; q < 4; ++q) { const bf16x8 ka = *(const LAS bf16x8*)(KET + (32 * q + r) * 144 + (16 * ks + 8 * hh) * 2); acc[q] = MFMA32(ka, vb, acc[q]); }
        }
        char* ob = (char*)(KVT + ((size_t)unit * 256 + 32 * C.wave) * 128); const unsigned olo = (unsigned)((r * 128 + 4 * hh) * 2);
#pragma unroll
        for (int q = 0; q < 4; ++q)
#pragma unroll
            for (int gq = 0; gq < 4; ++gq) { v2u w; w.x = cvtpk(acc[q][4 * gq], acc[q][4 * gq + 1]); w.y = cvtpk(acc[q][4 * gq + 2], acc[q][4 * gq + 3]);
                *(v2u*)(ob + olo + (32 * q + 8 * gq) * 2) = w; }
    }
}
__device__ __forceinline__ void gla_scan_phase(const Ctx& C) {
    const unsigned* KVT = (const unsigned*)(C.ws + WS_KVT); unsigned* SB = (unsigned*)(C.ws + WS_SB); const float* DEC = (const float*)(C.ws + WS_DEC);
    for (int it = C.bid * 512 + C.tid; it < 8 * 16384; it += C.G * 512) {
        const int bh = it >> 14, e2 = it & 16383, dk2 = (e2 & 63) * 2;
        float s0 = 0.f, s1 = 0.f;
#pragma unroll 1
        for (int n0 = 0; n0 < 64; n0 += 16) {
            unsigned kv[16]; float2 d[16];
#pragma unroll
            for (int j = 0; j < 16; ++j) { const size_t u = (size_t)bh * 64 + n0 + j; kv[j] = KVT[u * 16384 + e2]; d[j] = *(const float2*)(DEC + u * 128 + dk2); }
#pragma unroll
            for (int j = 0; j < 16; ++j) { const size_t u = (size_t)bh * 64 + n0 + j;
                SB[u * 16384 + e2] = cvtpk(s0, s1);
                s0 = d[j].x * s0 + bflo(kv[j]); s1 = d[j].y * s1 + bfhi(kv[j]); } }
    }
}
__device__ __forceinline__ void gla_c_phase(const Ctx& C, const Args& A, int first, int stride) {
    const bf16* PROJ = (const bf16*)(C.ws + WS_PROJ); const bf16* SB = (const bf16*)(C.ws + WS_SB); bf16* CAT = (bf16*)(C.ws + WS_CAT);
    const bf16* QIN = (const bf16*)(C.ws + WS_QIN); const bf16* KIN = (const bf16*)(C.ws + WS_KIN);
    const int lane = C.lane, r = lane & 31, hh = lane >> 5, i16 = lane & 15, blk = (lane >> 4) & 1;
    const unsigned ldsb = (unsigned)(unsigned long long)C.lds;
    LAS unsigned char* QI = C.lds + GL_QI; LAS unsigned char* KI = C.lds + GL_KI; LAS unsigned char* PM = C.lds + GL_PM; LAS float* OT = (LAS float*)(C.lds + GL_OT);
    const int kx = (r & 15) << 4;
    for (int unit = first; unit < 512; unit += stride) {
        const int bh = unit >> 6, n = unit & 63, b = bh >> 2, h = bh & 3; const size_t tok0 = (size_t)b * SEQ + 64 * n;
        __syncthreads();
        gla_stage_v(C, PROJ + tok0 * PROJ_N + PJ_GV + h * 256);
#pragma unroll
        for (int i = 0; i < 2; ++i) { const int pc = C.wave * 2 + i, row = 4 * pc + (lane >> 4), sch = (lane & 15) ^ (row & 15); const unsigned off = (unsigned)((row * 512 + sch * 8) * 2);
            glds16s(QIN + tok0 * 512 + h * 128, off, ldsb + GL_QI + pc * 1024); glds16s(KIN + tok0 * 512 + h * 128, off, ldsb + GL_KI + pc * 1024); }
        bf16x8 sf[8];
        { const char* sb = (const char*)(SB + ((size_t)unit * 256 + 32 * C.wave) * 128); const unsigned slo = (unsigned)((r * 128 + 8 * hh) * 2);
#pragma unroll
          for (int ks = 0; ks < 8; ++ks) sf[ks] = *(const bf16x8*)(sb + slo + 32 * ks); }
        asm volatile("s_waitcnt vmcnt(0)" ::: "memory");
        __syncthreads();
        if (C.wave < 4 && C.wave != 1) { const int tb = C.wave >> 1, sb = C.wave & 1;
            f32x16 am;
#pragma unroll
            for (int e = 0; e < 16; ++e) am[e] = 0.f;
#pragma unroll
            for (int ks = 0; ks < 8; ++ks) { const bf16x8 qa = *(const LAS bf16x8*)(QI + (32 * tb + r) * 256 + ((ks * 32 + hh * 16) ^ kx)), kb = *(const LAS bf16x8*)(KI + (32 * sb + r) * 256 + ((ks * 32 + hh * 16) ^ kx));
                am = MFMA32(qa, kb, am); }
#pragma unroll
            for (int e = 0; e < 16; ++e) { const int t = 32 * tb + (e & 3) + 8 * (e >> 2) + 4 * hh, s = 32 * sb + r;
                *(LAS unsigned short*)(PM + t * 144 + s * 2) = (unsigned short)f2bf(s <= t ? am[e] : 0.f); } }
        __syncthreads();
        f32x16 o[2];
#pragma unroll
        for (int tb = 0; tb < 2; ++tb)
#pragma unroll
            for (int e = 0; e < 16; ++e) o[tb][e] = 0.f;
#pragma unroll
        for (int ks = 0; ks < 8; ++ks)
#pragma unroll
            for (int tb = 0; tb < 2; ++tb) { const bf16x8 qa = *(const LAS bf16x8*)(QI + (32 * tb + r) * 256 + ((ks * 32 + hh * 16) ^ kx)); o[tb] = MFMA32(qa, sf[ks], o[tb]); }
        const LAS unsigned char* vt = C.lds + GL_V + C.wave * 512 + (i16 >> 2) * 64 + 32 * blk + 8 * (i16 & 3);
#pragma unroll
        for (int ks = 0; ks < 4; ++ks) {
            const s16x4 lo = tr_read(vt + ((2 * ks + hh) * 8) * 512), hi = tr_read(vt + ((2 * ks + hh) * 8) * 512 + 256);
            const bf16x8 vb = __builtin_shufflevector(lo, hi, 0, 1, 2, 3, 4, 5, 6, 7);
            if (ks < 2) { const bf16x8 pa = *(const LAS bf16x8*)(PM + r * 144 + (16 * ks + 8 * hh) * 2); o[0] = MFMA32(pa, vb, o[0]); }
            { const bf16x8 pa = *(const LAS bf16x8*)(PM + (32 + r) * 144 + (16 * ks + 8 * hh) * 2); o[1] = MFMA32(pa, vb, o[1]); }
        }
        __syncthreads();
#pragma unroll
        for (int tb = 0; tb < 2; ++tb)
#pragma unroll
            for (int e = 0; e < 16; ++e) OT[(32 * tb + (e & 3) + 8 * (e >> 2) + 4 * hh) * 260 + 32 * C.wave + r] = o[tb][e];
        __syncthreads();
        { const int t = C.tid >> 3, part = C.tid & 7; const size_t tok = tok0 + t;
          f32x4 v[8]; float ss = 0.f;
#pragma unroll
          for (int j = 0; j < 8; ++j) { v[j] = *(const LAS f32x4*)(OT + t * 260 + 32 * part + 4 * j); ss += (v[j].x * v[j].x + v[j].y * v[j].y) + (v[j].z * v[j].z + v[j].w * v[j].w); }
          ss += __shfl_xor(ss, 1); ss += __shfl_xor(ss, 2); ss += __shfl_xor(ss, 4);
          const float rstd = rsqrtf(ss * (1.f / 256.f) + EPS);
          const v4u* grp = (const v4u*)(PROJ + tok * PROJ_N + PJ_GR + h * 256 + 32 * part); const f32x4* gnp = (const f32x4*)(A.in[I_GLA_NORM] + 32 * part);
          v4u* op = (v4u*)(CAT + tok * LDP + h * 256 + 32 * part);
          v4u gwv[4]; f32x4 gnv[8];
#pragma unroll
          for (int q = 0; q < 4; ++q) { gwv[q] = grp[q]; gnv[2 * q] = gnp[2 * q]; gnv[2 * q + 1] = gnp[2 * q + 1]; }
#pragma unroll
          for (int q = 0; q < 4; ++q) { const v4u gw = gwv[q]; const f32x4 a = v[2 * q] * rstd * gnv[2 * q], c = v[2 * q + 1] * rstd * gnv[2 * q + 1];
              v4u w; w.x = cvtpk(a.x * silu(bflo(gw.x)), a.y * silu(bfhi(gw.x))); w.y = cvtpk(a.z * silu(bflo(gw.y)), a.w * silu(bfhi(gw.y)));
              w.z = cvtpk(c.x * silu(bflo(gw.z)), c.y * silu(bfhi(gw.z))); w.w = cvtpk(c.z * silu(bflo(gw.w)), c.w * silu(bfhi(gw.w)));
              op[q] = w; } }
    }
}

__device__ __forceinline__ void fox_knorm_phase(const Ctx& C) {
    const bf16* PROJ = (const bf16*)(C.ws + WS_PROJ); unsigned* KM = (unsigned*)(C.ws + WS_CTL) + CW_KMAX;
    for (int blk = C.gw; blk < 16 * SEQ / 32; blk += C.ngw) {
        const int bh = blk >> 7, b = bh >> 3, h = bh & 7; float mx = 0.f;
#pragma unroll
        for (int i = 0; i < 8; ++i) { const int s = (blk & 127) * 32 + 4 * i + (C.lane >> 4);
            const v4u w = *(const v4u*)(PROJ + ((size_t)b * SEQ + s) * PROJ_N + PJ_FK + h * 128 + 8 * (C.lane & 15));
            float q = bflo(w.x) * bflo(w.x) + bfhi(w.x) * bfhi(w.x) + bflo(w.y) * bflo(w.y) + bfhi(w.y) * bfhi(w.y) + bflo(w.z) * bflo(w.z) + bfhi(w.z) * bfhi(w.z) + bflo(w.w) * bflo(w.w) + bfhi(w.w) * bfhi(w.w);
            q += __shfl_xor(q, 1); q += __shfl_xor(q, 2); q += __shfl_xor(q, 4); q += __shfl_xor(q, 8);
            mx = fmaxf(mx, q); }
        mx = fmaxf(mx, __shfl_xor(mx, 16)); mx = fmaxf(mx, __shfl_xor(mx, 32));
        if (C.lane == 0) atomicMax(KM + bh, __float_as_uint(mx));
    }
}
__device__ __forceinline__ void router_phase(const Ctx& C, const Args& A) {
    const float* H2 = (const float*)(C.ws + WS_H2); bf16* XN = (bf16*)(C.ws + WS_XN);
    int* TOPE = (int*)(C.ws + WS_TOPE); float* TOPG = (float*)(C.ws + WS_TOPG); int* CNT = (int*)(C.ws + WS_CNT);
    const float* wr = A.in[I_W_ROUTER]; const float* br = A.in[I_B_ROUTER]; const float* nm = A.in[I_NORM_MOE];
    LAS int* cnt = (LAS int*)(C.lds); LAS float* RS = (LAS float*)(C.lds + 256); LAS float* PART = (LAS float*)(C.lds + 1024); LAS float* LG = (LAS float*)(C.lds + 1024 + 32768);
    const int lane = C.lane, tl = lane & 31, kk = lane >> 5;
    for (int blk = C.bid; blk < 256; blk += C.G) {
        __syncthreads();
        if (C.tid < 32) cnt[C.tid] = 0;
        rows32_proj<1>(C, blk, H2, nm, wr, NE, lane & 31, XN);
        if (C.tid < 32) { const int t = blk * 32 + C.tid;
            float lg[32];
#pragma unroll
            for (int e = 0; e < 32; ++e) lg[e] = LG[C.tid * 33 + e] + br[e];
            unsigned taken = 0u; int te[4]; float tv[4];
#pragma unroll
            for (int k4 = 0; k4 < 4; ++k4) { float best = -3.0e38f; int bi = 0;
#pragma unroll
                for (int e = 0; e < 32; ++e) { const bool ok = !((taken >> e) & 1u) && (lg[e] > best); best = ok ? lg[e] : best; bi = ok ? e : bi; }
                taken |= 1u << bi; te[k4] = bi; tv[k4] = best; }
            const float p1 = __expf(tv[1] - tv[0]), p2 = __expf(tv[2] - tv[0]), p3 = __expf(tv[3] - tv[0]); const float inv = 1.f / (1.f + p1 + p2 + p3);
            TOPE[t * 4 + 0] = te[0]; TOPE[t * 4 + 1] = te[1]; TOPE[t * 4 + 2] = te[2]; TOPE[t * 4 + 3] = te[3];
            TOPG[t * 4 + 0] = inv; TOPG[t * 4 + 1] = p1 * inv; TOPG[t * 4 + 2] = p2 * inv; TOPG[t * 4 + 3] = p3 * inv;
            atomicAdd((int*)&cnt[te[0]], 1); atomicAdd((int*)&cnt[te[1]], 1); atomicAdd((int*)&cnt[te[2]], 1); atomicAdd((int*)&cnt[te[3]], 1);
        }
        __syncthreads();
        if (C.tid < 32) CNT[blk * 32 + C.tid] = cnt[C.tid];
        __syncthreads();
    }
}
__device__ __forceinline__ void place_phase(const Ctx& C) {
    const int* CNT = (const int*)(C.ws + WS_CNT); const int* TOPE = (const int*)(C.ws + WS_TOPE);
    int* TSLOT = (int*)(C.ws + WS_TSLOT); int* RT = (int*)(C.ws + WS_RT);
    const unsigned char* XN = (const unsigned char*)(C.ws + WS_XN); unsigned char* XS = (unsigned char*)(C.ws + WS_XS);
    LAS int* tot = (LAS int*)(C.lds); LAS int* pre = tot + 32; LAS int* ps = pre + 32; LAS int* slot_of = ps + 32; LAS int* te = slot_of + 128; LAS int* sseg = te + 128; LAS int* pseg = sseg + 512;
    for (int blk = C.bid; blk < 256; blk += C.G) {
        { const int e = C.tid & 31, seg = C.tid >> 5; int s = 0, p = 0;
#pragma unroll 16
          for (int w = seg * 16; w < seg * 16 + 16; ++w) { const int c = CNT[w * 32 + e]; s += c; p += (w < blk) ? c : 0; }
          sseg[seg * 32 + e] = s; pseg[seg * 32 + e] = p; }
        if (C.tid < 128) te[C.tid] = TOPE[blk * 128 + C.tid];
        __syncthreads();
        if (C.tid < 32) { int tt = 0, pp = 0;
#pragma unroll
            for (int q = 0; q < 16; ++q) { tt += sseg[q * 32 + C.tid]; pp += pseg[q * 32 + C.tid]; }
            tot[C.tid] = tt; pre[C.tid] = pp; }
        __syncthreads();
        if (C.tid == 0) { int run = 0; for (int e = 0; e < 32; ++e) { ps[e] = run; run += (tot[e] + 127) & ~127; } }
        __syncthreads();
        if (C.tid < 32) { int base = ps[C.tid] + pre[C.tid];
            for (int a = 0; a < 128; ++a) if (te[a] == C.tid) { slot_of[a] = base; TSLOT[blk * 128 + a] = base; ++base; } }
        __syncthreads();
        { v4u rowv[4][2];
#pragma unroll
          for (int q = 0; q < 4; ++q) { const v4u* src = (const v4u*)(XN + (size_t)(blk * 32 + C.wave * 4 + q) * D) + C.lane; rowv[q][0] = src[0]; rowv[q][1] = src[64]; }
#pragma unroll
          for (int q = 0; q < 4; ++q)
#pragma unroll
              for (int k = 0; k < 4; ++k) { const int sl = slot_of[C.wave * 16 + q * 4 + k]; v4u* dst = (v4u*)(XS + (size_t)sl * D) + C.lane; dst[0] = rowv[q][0]; dst[64] = rowv[q][1]; } }
        if (blk == 0) {
            LAS int* rtl = sseg; LAS int* eul = sseg + 600;
            __syncthreads();
            if (C.tid < 64) {
                const int e = C.tid & 31, n = tot[e], nt = (n + 255) >> 8; int inc = nt;
#pragma unroll
                for (int o_ = 1; o_ < 32; o_ <<= 1) { const int t_ = __shfl_up(inc, o_); if ((C.tid & 31) >= o_) inc += t_; }
                const int first = inc - nt;
                if (C.tid < 32) { eul[e] = first; if (e == 31) { eul[32] = inc; RT[0] = inc; }
                    for (int q = 0; q < nt; ++q) { rtl[3 * (first + q)] = (ps[e] >> 7) + 2 * q; const int rem = n - 256 * q; rtl[3 * (first + q) + 1] = rem < 256 ? rem : 256; rtl[3 * (first + q) + 2] = e; } } }
            __syncthreads();
            const int nrt = eul[32]; int* UL = (int*)(C.ws + WS_UL);
#pragma unroll 1
            for (int pass = 0; pass < 2; ++pass) { const int NT = pass ? 8 : 16; int* ul = UL + (pass ? 8192 : 0);
                for (int u = C.tid; u < nrt * NT; u += 512) { int e = 0;
                    for (int q = 1; q < 32; ++q) e += (u >= eul[q] * NT) ? 1 : 0;
                    const int n = eul[e + 1] - eul[e], lu = u - eul[e] * NT, pn = lu / n, ti = eul[e] + lu % n;
                    ul[3 * u] = rtl[3 * ti]; ul[3 * u + 1] = rtl[3 * ti + 1]; ul[3 * u + 2] = e * NT + pn; } }
        }
        __syncthreads();
    }
}
__device__ __forceinline__ void final_phase(const Ctx& C, const Args& A) {
    const float* H2 = (const float*)(C.ws + WS_H2); const unsigned char* YY = (const unsigned char*)(C.ws + WS_YY);
    const int* TSLOT = (const int*)(C.ws + WS_TSLOT); const float* TOPG = (const float*)(C.ws + WS_TOPG); const float* nf = A.in[I_NORM_FINAL];
    for (int t0 = 2 * C.gw; t0 < T; t0 += 2 * C.ngw) {
        int sl[2][4]; float gt[2][4];
#pragma unroll
        for (int p = 0; p < 2; ++p)
#pragma unroll
            for (int k = 0; k < 4; ++k) { sl[p][k] = TSLOT[(t0 + p) * 4 + k]; gt[p][k] = TOPG[(t0 + p) * 4 + k] * (1.f / Y8_SCALE); }
        f32x4 v[2][8]; unsigned yw[2][4][8];
#pragma unroll
        for (int p = 0; p < 2; ++p) { const f32x4* xr = (const f32x4*)(H2 + (size_t)(t0 + p) * D) + C.lane;
#pragma unroll
            for (int j = 0; j < 8; ++j) v[p][j] = xr[64 * j];
#pragma unroll
            for (int k = 0; k < 4; ++k) { const unsigned* yr = (const unsigned*)(YY + (size_t)sl[p][k] * D) + C.lane;
#pragma unroll
                for (int j = 0; j < 8; ++j) yw[p][k][j] = yr[64 * j]; } }
#pragma unroll
        for (int p = 0; p < 2; ++p) {
#pragma unroll
            for (int k = 0; k < 4; ++k) { const float g = gt[p][k];
#pragma unroll
                for (int j = 0; j < 8; ++j) { const unsigned w = yw[p][k][j];
                    const auto lo = __builtin_amdgcn_cvt_pk_f32_fp8((int)w, false), hi = __builtin_amdgcn_cvt_pk_f32_fp8((int)w, true);
                    v[p][j].x += g * lo[0]; v[p][j].y += g * lo[1]; v[p][j].z += g * hi[0]; v[p][j].w += g * hi[1]; } }
            float s = 0.f;
#pragma unroll
            for (int j = 0; j < 8; ++j) s += (v[p][j].x * v[p][j].x + v[p][j].y * v[p][j].y) + (v[p][j].z * v[p][j].z + v[p][j].w * v[p][j].w);
            const float rstd = rsqrtf(wave_sum(s) * (1.f / D) + EPS);
            f32x4* o = (f32x4*)(A.out + (size_t)(t0 + p) * D) + C.lane; const f32x4* gr = (const f32x4*)nf + C.lane;
#pragma unroll
            for (int j = 0; j < 8; ++j) o[64 * j] = v[p][j] * rstd * gr[64 * j]; }
    }
}

template <int K> __device__ __forceinline__ void run_phase(const Ctx& C0, const Args& args, const XcdBarrier& bar) {
    Ctx C = C0; { int t_ = lane_id(); asm volatile("" : "+v"(t_)); C.lane = t_; C.tid = C.wave * 64 + t_; }
    unsigned char* ws = args.ws; LAS unsigned char* ring = C.lds + RING_OFF; (void)ws; (void)ring; (void)bar;
    if constexpr (K == 0) { p0_prologue(C, args); }
    if constexpr (K == 1) { cumsum_cf(C);
        pg8::Gemm g{(const bf16*)(ws + WS_XN), (const bf16*)(ws + WS_WT_IN), T, PROJ_N, D}; pg8::StaticOrder S; S.init(T, PROJ_N, C.G, C.bid);
        pg8::EpiBf16S E{(bf16*)(ws + WS_PROJ), PROJ_N, 0.08838834764831845f, 2, nullptr};
#ifdef PROBE_QCONV
        { const int grp_ = (C.bid >> 3) & 3; Ctx C2 = C; C2.gw = (((C.bid >> 5) * 8 + (C.bid & 7)) * 8 + C.wave); C2.ngw = 512;
        if (grp_ == 0) { conv_items_f8(C2, args, 0, 128); conv_dense(C2, args, 3072, 8192); __syncthreads(); }
        pg8::gemm_phase<pg8::EpiBf16S, pg8::StaticOrder, true, true>(ring, g, S, E, C.wave); } }
#else
        { const bool par_ = (C.bid >> 3) & 1;
        if (par_) { conv_items_f8(C, args, 0, 32); conv_dense(C, args, 3072, 8192); __syncthreads(); }
        pg8::gemm_phase<pg8::EpiBf16S, pg8::StaticOrder, true, true>(ring, g, S, E, C.wave);
        if (!par_) { __syncthreads(); conv_items_f8(C, args, 0, 32); conv_dense(C, args, 3072, 8192); } } }
#endif
    if constexpr (K == 2) { gla_a_phase(C, args); fox_knorm_phase(C); }
    if constexpr (K == 3) { gla_scan_phase(C); __syncthreads(); fox_phase(C); xcd_barrier(bar);
        const int nkv = (C.G >= 128) ? 64 : 0;
        if (C.bid >= C.G - nkv) { pg8::Gemm g{(const bf16*)(ws + WS_MEMN), (const bf16*)(ws + WS_WT_XKV), NB * MEM_LEN, 2 * D, D}; pg8::HalfOrder S{4, 16, C.bid - (C.G - nkv), nkv};
            pg8::EpiBf16S E{(bf16*)(ws + WS_KV2), 2 * D, 1.f, 0, nullptr};
            pg8::gemm_phase<pg8::EpiBf16S, pg8::HalfOrder, true, true, false, true>(ring, g, S, E, C.wave); }
        else gla_c_phase(C, args, C.bid, C.G - nkv);
        if (nkv == 0) { pg8::Gemm g{(const bf16*)(ws + WS_MEMN), (const bf16*)(ws + WS_WT_XKV), NB * MEM_LEN, 2 * D, D}; pg8::HalfOrder S{4, 16, C.bid, C.G};
            pg8::EpiBf16S E{(bf16*)(ws + WS_KV2), 2 * D, 1.f, 0, nullptr}; __syncthreads();
            pg8::gemm_phase<pg8::EpiBf16S, pg8::HalfOrder, true, true, false, true>(ring, g, S, E, C.wave); } }
    if constexpr (K == 4) { pg8::Gemm g{(const bf16*)(ws + WS_CAT), (const bf16*)(ws + WS_WT_OUT), T, D, D, LDP}; pg8::StaticOrder S; S.init(T, D, C.G, C.bid);
        pg8::EpiF32ResNorm E{args.in[I_X], (float*)(ws + WS_H1), D, args.in[I_NORM_XATTN], (unsigned char*)(ws + WS_XN), (float*)(ws + WS_SSP), X8_SCALE};
        pg8::gemm_phase<pg8::EpiF32ResNorm, pg8::StaticOrder, false, true>(ring, g, S, E, C.wave); }
    if constexpr (K == 5) { }
    if constexpr (K == 6) { pg8::Gemm g{(const bf16*)(ws + WS_XN), (const bf16*)(ws + WS_WT_XQ), T, D, D / 2}; pg8::StaticOrder S; S.init(T, D, C.G, C.bid);
        LAS float* rtab = (LAS float*)(C.lds + 131072);
        { pg8::Unit u0; if (S.next(0, u0) && C.tid < 256) { const f32x4* sp = (const f32x4*)((const float*)(ws + WS_SSP) + (size_t)(u0.a128 * 128 + C.tid) * 32); f32x4 t = sp[0];
#pragma unroll
              for (int q = 1; q < 8; ++q) t += sp[q];
              rtab[C.tid] = rsqrtf(((t.x + t.y) + (t.z + t.w)) * (1.f / 2048.f) + EPS); } }
        __syncthreads();
        pg8::EpiBf16S E{(bf16*)(ws + WS_Q2), D, 0.04419417382415922f * 1.4426950408889634f / (X8_SCALE * W8_SCALE), 8, rtab};
        pg8::gemm_phase<pg8::EpiBf16S, pg8::StaticOrder, false, true, true>(ring, g, S, E, C.wave); }
    if constexpr (K == 7) { xattn_phase(C); }
    if constexpr (K == 8) { pg8::Gemm g{(const bf16*)(ws + WS_XO), (const bf16*)(ws + WS_WT_XO), T, D, D / 2}; pg8::StaticOrder S; S.init(T, D, C.G, C.bid);
        pg8::EpiF32Res E{(const float*)(ws + WS_H1), (float*)(ws + WS_H2), D, 1.f / (O8_SCALE * W8_SCALE)};
        pg8::gemm_phase<pg8::EpiF32Res, pg8::StaticOrder, false, true, true>(ring, g, S, E, C.wave); }
    if constexpr (K == 9) { router_phase(C, args); }
    if constexpr (K == 10) { place_phase(C); }
    if constexpr (K == 11) { const int* RT = (const int*)(ws + WS_RT);
        const int nwg_ = __builtin_amdgcn_readfirstlane(RT[0]) * 16;
        pg8::Gemm g{(const bf16*)(ws + WS_XS), (const bf16*)(ws + WS_WT_GU), 0, 2 * DFF, D / 2}; LAS int* utab_ = (LAS int*)(C.lds + LDSCTL_OFF + 1024);
        pg8::MoeOrder S{(const int*)(ws + WS_UL), nwg_, C.G, C.bid, 1, utab_}; S.fill(utab_, C.tid); __syncthreads();
        pg8::EpiGateUp E{(unsigned char*)(ws + WS_HH), DFF, args.in[I_B_GU], 1.f / (X8_SCALE * W8_SCALE), H8_SCALE};
        { const bool par_ = (C.bid >> 3) & 1;
          const int nmax_ = (nwg_ + C.G - 1) / C.G, rem_ = nwg_ - (nmax_ - 1) * C.G; const bool hv_ = 2 * rem_ <= C.G;
          const int X_ = hv_ ? 2 * rem_ : rem_, dp_ = hv_ ? 2 : 3, L256_ = 2048 + dp_ * X_, H256_ = L256_ - 256 * dp_;
          const int c0_ = C.bid, c1_ = C.bid + 1;
          const int cum0_ = c0_ < X_ ? c0_ * H256_ : X_ * H256_ + (c0_ - X_) * L256_, cum1_ = c1_ < X_ ? c1_ * H256_ : X_ * H256_ + (c1_ - X_) * L256_;
          const int s_lo_ = 2 * (cum0_ >> 8), s_hi_ = 2 * (cum1_ >> 8);
          Ctx C2 = C; C2.ngw = 8; C2.gw = 65536 + C.wave;
          const bool conv_ = s_lo_ < s_hi_;
          const int kcut_ = 3 * ((C.bid >> 3) & 3); (void)par_;
#pragma unroll 1
          for (int seg_ = 0; seg_ < 2; ++seg_) { S.lo = seg_ ? kcut_ : 0; S.hi = seg_ ? 16 : kcut_;
              pg8::gemm_phase<pg8::EpiGateUp, pg8::MoeOrder, true, true, true, true>(ring, g, S, E, C.wave);
              if (seg_ == 0) { __syncthreads(); if (conv_) conv_items_f8(C2, args, s_lo_, s_hi_); __syncthreads(); } } } }
    if constexpr (K == 12) { const int* RT = (const int*)(ws + WS_RT);
        pg8::Gemm g{(const bf16*)(ws + WS_HH), (const bf16*)(ws + WS_WT_DN), 0, D, DFF / 2}; LAS int* utab_ = (LAS int*)(C.lds + LDSCTL_OFF + 1024);
        pg8::MoeOrder S{(const int*)(ws + WS_UL) + 8192, __builtin_amdgcn_readfirstlane(RT[0]) * 8, C.G, C.bid, 1, utab_}; S.fill(utab_, C.tid); __syncthreads();
        pg8::EpiDown E{(unsigned char*)(ws + WS_YY), D, args.in[I_B_DN], 1.f / (H8_SCALE * W8_SCALE), Y8_SCALE};
        pg8::gemm_phase<pg8::EpiDown, pg8::MoeOrder, true, true, true, true>(ring, g, S, E, C.wave); }
    if constexpr (K == 13) { final_phase(C, args); }
}

__global__ void __launch_bounds__(NWAVES * 64, 2) mk_fwd(Args args) {
    extern __shared__ __attribute__((aligned(16))) unsigned char lds[];
    Ctx C;
    C.lds = (LAS unsigned char*)lds; C.ws = args.ws;
    C.tid = threadIdx.x; C.lane = C.tid & 63; C.wave = __builtin_amdgcn_readfirstlane(C.tid >> 6);
    C.G = gridDim.x; C.bid = blockIdx.x; C.gw = C.bid * NWAVES + C.wave; C.ngw = C.G * NWAVES;
    volatile LAS unsigned* MISC = (volatile LAS unsigned*)(C.lds + MISC_OFF);
    for (int u = C.tid; u < (LDS_BYTES - LDSCTL_OFF) / 4; u += NWAVES * 64) ((LAS unsigned*)(C.lds + LDSCTL_OFF))[u] = 0u;
    __syncthreads();
    unsigned* ctl = (unsigned*)(args.ws + WS_CTL);
    XcdBarrier bar; bar.bar = ctl + CW_BAR; bar.x = 0; bar.st = nullptr;
    if (MK_N_LAUNCHES == 1) bar = xcd_barrier_post(ctl + CW_BAR, MISC + 8);
    const int lo = args.ph_lo, hi = args.ph_hi;
#define IN(k) (lo <= (k) && (k) < hi)
#define SEAM(k) do { if (IN(k) && IN((k) + 1)) xcd_barrier(bar); } while (0)
    unsigned char* ws = args.ws;
    LAS unsigned char* ring = C.lds + RING_OFF;

#define PH(k) do { if (IN(k)) { run_phase<k>(C, args, bar); if (PROBE_REP == (k)) { xcd_barrier(bar); run_phase<k>(C, args, bar); } } SEAM(k); } while (0)
    PH(0); PH(1); PH(2); PH(3); PH(4); PH(6); PH(7); PH(8); PH(9); PH(10); PH(11); PH(12); PH(13);
#undef PH
#undef IN
#undef SEAM
}

extern "C" void kernel_launch(void* const* d_in, const int* in_sizes, int n_in, void* d_out, int out_size, void* d_ws, size_t ws_size, hipStream_t stream) {
    static int grid = 0;
    if (grid == 0) {
        if (n_in != 22 || out_size != T * D || ws_size < WS_END) { fprintf(stderr, "kernel_launch: unexpected shapes (n_in %d out %d ws %zu need %zu)\n", n_in, out_size, ws_size, (size_t)WS_END); grid = -1; return; }
        int dev = 0, cus = 0, per_cu = 0;
        if (hipGetDevice(&dev) != hipSuccess || hipDeviceGetAttribute(&cus, hipDeviceAttributeMultiprocessorCount, dev) != hipSuccess) { grid = -1; return; }
        if (hipFuncSetAttribute((const void*)mk_fwd, hipFuncAttributeMaxDynamicSharedMemorySize, LDS_BYTES) != hipSuccess) { fprintf(stderr, "kernel_launch: hipFuncSetAttribute failed\n"); grid = -1; return; }
        if (hipOccupancyMaxActiveBlocksPerMultiprocessor(&per_cu, (const void*)mk_fwd, NWAVES * 64, LDS_BYTES) != hipSuccess || per_cu < 1) fprintf(stderr, "kernel_launch: occupancy query says %d\n", per_cu);
        (void)hipGetLastError();
        if (cus != 256) { fprintf(stderr, "kernel_launch: built for a 256-CU MI355X (one workgroup per CU); this device reports %d CUs: nothing launched\n", cus); grid = -1; return; }
        grid = cus;
    }
    if (grid < 0) return;
    if (hipMemsetAsync((char*)d_ws + WS_CTL, 0, CTL_ZERO_BYTES, stream) != hipSuccess) return;
    Args a{};
    for (int i = 0; i < 22; ++i) a.in[i] = (const float*)d_in[i];
    a.out = (float*)d_out; a.ws = (unsigned char*)d_ws;
    if (MK_N_LAUNCHES == 1) { a.ph_lo = 0; a.ph_hi = N_PHASES; hipLaunchKernelGGL(mk_fwd, dim3(grid), dim3(NWAVES * 64), LDS_BYTES, stream, a); }
    else for (int p = 0; p < N_PHASES; ++p) { a.ph_lo = p; a.ph_hi = p + 1; hipLaunchKernelGGL(mk_fwd, dim3(grid), dim3(NWAVES * 64), LDS_BYTES, stream, a); }
}
```
